# Optimizing an MI355X kernel written in HIP

```python
import math
import jax, jax.numpy as jnp
from jax import lax
import numpy as np

D_MODEL = 2048
BATCH = 4
SEQ = 2048
DEPTH = 1
DEC_BATCH = 4
DEC_SEQ = 8192
PAST_LEN = 128

N_MEM = 256
D_MIX = D_MODEL
EPS = 1e-6
SSD_WIDTH = D_MIX // 2
SSD_HEAD_DIM = 64
SSD_HEADS = SSD_WIDTH // SSD_HEAD_DIM
SSD_GROUPS = 2
SSD_STATE = 128
SSD_CHUNK = 128
D_CONV = 5
CONV_CH = SSD_WIDTH + 2 * SSD_GROUPS * SSD_STATE
DT_MIN = 1e-3
DT_MAX = 1e-1
ATT_WIDTH = D_MIX // 4
ATT_HEAD_DIM = 64
ATT_HEADS = ATT_WIDTH // ATT_HEAD_DIM
ATT_KV_HEADS = 2
WINDOW = 128
BLOCK = 128
MEM_WIDTH = D_MIX - SSD_WIDTH - ATT_WIDTH
MEM_HEADS = 4
MEM_HEAD_DIM = MEM_WIDTH // MEM_HEADS
IN_SIZES = (CONV_CH, SSD_WIDTH, 2 * SSD_HEADS,
            ATT_HEADS * ATT_HEAD_DIM, ATT_KV_HEADS * ATT_HEAD_DIM, ATT_KV_HEADS * ATT_HEAD_DIM, ATT_WIDTH,
            MEM_WIDTH, MEM_WIDTH)
D_IN = sum(IN_SIZES)

kernel_name = 'hymba_bidir_ssd_swa_mem_encoder'


def rms_norm(x, g):
    xf = x.astype(jnp.float32)
    y = xf * lax.rsqrt(jnp.mean(xf * xf, axis=-1, keepdims=True) + EPS)
    return (y * g.astype(jnp.float32)).astype(x.dtype)


def split_cols(x, sizes):
    idx = np.cumsum(sizes)[:-1].tolist()
    return jnp.split(x, idx, axis=-1)


def centred_dwconv(u, w, b):
    K = w.shape[0]
    out = lax.conv_general_dilated(u, w[:, None, :].astype(u.dtype), window_strides=(1,),
                                   padding=[((K - 1) // 2, K // 2)],
                                   dimension_numbers=('NWC', 'WIO', 'NWC'),
                                   feature_group_count=u.shape[-1])
    return out + b.astype(u.dtype)


def ssd_scan(x, dt, A, Bm, Cm):
    b, T, h, p = x.shape
    g, n = Bm.shape[2], Bm.shape[3]
    r = h // g
    L = SSD_CHUNK
    c = T // L
    f32 = jnp.float32
    xs = x.astype(f32).reshape(b, c, L, g, r, p)
    dt = dt.astype(f32).reshape(b, c, L, g, r)
    Bm = Bm.astype(f32).reshape(b, c, L, g, n)
    Cm = Cm.astype(f32).reshape(b, c, L, g, n)
    acs = jnp.cumsum(dt * A.astype(f32).reshape(g, r), axis=2)
    xdt = xs * dt[..., None]
    seg = acs[:, :, :, None] - acs[:, :, None, :]
    tril = jnp.tril(jnp.ones((L, L), dtype=bool))[:, :, None, None]
    decay = jnp.exp(jnp.where(tril, seg, -jnp.inf))
    cb = jnp.einsum('bcign,bcjgn->bcijg', Cm, Bm)
    y_diag = jnp.einsum('bcijgr,bcjgrp->bcigrp', cb[..., None] * decay, xdt)
    decay_end = jnp.exp(acs[:, :, -1:] - acs)
    states = jnp.einsum('bcjgn,bcjgrp->bcgrpn', Bm, xdt * decay_end[..., None])
    chunk_decay = jnp.exp(acs[:, :, -1])

    def step(S, inp):
        dA, st = inp
        return dA[..., None, None] * S + st, S

    S0 = jnp.zeros((b, g, r, p, n), f32)
    _, S_prev = lax.scan(step, S0, (jnp.moveaxis(chunk_decay, 1, 0), jnp.moveaxis(states, 1, 0)))
    S_prev = jnp.moveaxis(S_prev, 0, 1)
    y_off = jnp.einsum('bcign,bcgrpn->bcigrp', Cm, S_prev) * jnp.exp(acs)[..., None]
    return (y_diag + y_off).reshape(b, T, h, p).astype(x.dtype)


def alibi_slopes(n_heads):
    return 2.0 ** (-8.0 * jnp.arange(1, n_heads + 1, dtype=jnp.float32) / n_heads)


def window_attention(q, k, v, sink):
    b, T, H, d = q.shape
    KV = k.shape[2]
    r = H // KV
    nb = T // BLOCK
    qb = q.reshape(b, nb, BLOCK, KV, r, d)
    pad = ((0, 0), (BLOCK, BLOCK), (0, 0), (0, 0))
    kp = jnp.pad(k, pad).reshape(b, nb + 2, BLOCK, KV, d)
    vp = jnp.pad(v, pad).reshape(b, nb + 2, BLOCK, KV, d)
    kw = jnp.concatenate([kp[:, :-2], kp[:, 1:-1], kp[:, 2:]], axis=2)
    vw = jnp.concatenate([vp[:, :-2], vp[:, 1:-1], vp[:, 2:]], axis=2)
    s = jnp.einsum('bnqgrd,bnkgd->bngrqk', qb, kw).astype(jnp.float32) * (d ** -0.5)
    blk = jnp.arange(nb)[:, None] * BLOCK
    qpos = blk + jnp.arange(BLOCK)[None, :]
    kpos = blk - BLOCK + jnp.arange(3 * BLOCK)[None, :]
    dist = jnp.abs(qpos[:, :, None] - kpos[:, None, :]).astype(jnp.float32)
    valid = (dist <= WINDOW) & ((kpos >= 0) & (kpos < T))[:, None, :]
    slopes = alibi_slopes(H).reshape(KV, r)
    logits = jnp.where(valid[:, None, None], s - slopes[None, :, :, None, None] * dist[:, None, None], -jnp.inf)
    sk = sink.astype(jnp.float32).reshape(KV, r)[:, :, None, None]
    m = jnp.maximum(jnp.max(logits, axis=-1, keepdims=True), sk)
    pr = jnp.exp(logits - m)
    probs = pr / (jnp.sum(pr, axis=-1, keepdims=True) + jnp.exp(sk - m))
    o = jnp.einsum('bngrqk,bnkgd->bnqgrd', probs.astype(v.dtype), vw)
    return o.reshape(b, T, H * d)


def layer(x, mem, norm_g, w_in, conv_w, conv_b, dt_bias, a_log, d_skip, ssd_norm_g,
          q_norm_g, k_norm_g, sink, mem_norm_g, w_mem_kv, mq_norm_g, mk_norm_g, w_out):
    b, T, _ = x.shape
    hn = rms_norm(x, norm_g)
    proj = hn @ w_in
    xbc, z_ssd, dt_raw, q, k, v, z_att, mq, z_mem = split_cols(proj, IN_SIZES)

    xbc = jax.nn.silu(centred_dwconv(xbc, conv_w, conv_b))
    xs, Bm, Cm = split_cols(xbc, (SSD_WIDTH, SSD_GROUPS * SSD_STATE, SSD_GROUPS * SSD_STATE))
    xs = xs.reshape(b, T, SSD_HEADS, SSD_HEAD_DIM)
    Bm = Bm.reshape(b, T, SSD_GROUPS, SSD_STATE)
    Cm = Cm.reshape(b, T, SSD_GROUPS, SSD_STATE)
    dt = jax.nn.softplus(dt_raw.astype(jnp.float32).reshape(b, T, 2, SSD_HEADS) + dt_bias.astype(jnp.float32))
    A = -jnp.exp(a_log.astype(jnp.float32))
    y_f = ssd_scan(xs, dt[:, :, 0], A[0], Bm, Cm)
    y_b = ssd_scan(xs[:, ::-1], dt[:, ::-1, 1], A[1], Bm[:, ::-1], Cm[:, ::-1])[:, ::-1]
    y = (y_f + y_b + d_skip[:, None] * xs).reshape(b, T, SSD_WIDTH)
    yg = (y * jax.nn.silu(z_ssd)).reshape(b, T, SSD_GROUPS, SSD_WIDTH // SSD_GROUPS)
    o_ssd = rms_norm(yg, ssd_norm_g.reshape(SSD_GROUPS, SSD_WIDTH // SSD_GROUPS)).reshape(b, T, SSD_WIDTH)

    q = rms_norm(q.reshape(b, T, ATT_HEADS, ATT_HEAD_DIM), q_norm_g)
    k = rms_norm(k.reshape(b, T, ATT_KV_HEADS, ATT_HEAD_DIM), k_norm_g)
    v = v.reshape(b, T, ATT_KV_HEADS, ATT_HEAD_DIM)
    o_att = window_attention(q, k, v, sink) * jax.nn.silu(z_att)

    memn = rms_norm(mem, mem_norm_g)
    mk, mv = split_cols(memn @ w_mem_kv, (MEM_WIDTH, MEM_WIDTH))
    M = mem.shape[1]
    mk = rms_norm(mk.reshape(b, M, MEM_HEADS, MEM_HEAD_DIM), mk_norm_g)
    mv = mv.reshape(b, M, MEM_HEADS, MEM_HEAD_DIM)
    mq = rms_norm(mq.reshape(b, T, MEM_HEADS, MEM_HEAD_DIM), mq_norm_g)
    sm = jnp.einsum('bthd,bmhd->bhtm', mq, mk).astype(jnp.float32) * (MEM_HEAD_DIM ** -0.5)
    pm = jax.nn.softmax(sm, axis=-1).astype(mv.dtype)
    o_mem = jnp.einsum('bhtm,bmhd->bthd', pm, mv).reshape(b, T, MEM_WIDTH) * jax.nn.silu(z_mem)

    return x + jnp.concatenate([o_ssd, o_att, o_mem], axis=-1) @ w_out


def trunk(x, mem, params):
    for l in range(DEPTH):
        x = layer(x, mem, *[p[l] for p in params])
    return x


def setup_inputs(seed: int = 0) -> dict:
    key = jax.random.key(seed)
    ks = jax.random.split(key, 24)
    f32 = jnp.float32

    def nrm(k, shape, scale):
        return jax.random.normal(k, shape, f32) * scale

    u = jax.random.uniform(ks[8], (DEPTH, 2, SSD_HEADS), f32)
    dt0 = jnp.exp(u * (math.log(DT_MAX) - math.log(DT_MIN)) + math.log(DT_MIN))
    return {
        'x_prompt': nrm(ks[0], (BATCH, SEQ, D_MODEL), 1.0),
        'x_sample': nrm(ks[1], (DEC_BATCH, DEC_SEQ, D_MODEL), 1.0),
        'mem_prompt': nrm(ks[2], (BATCH, N_MEM, D_MODEL), 1.0),
        'mem_sample': nrm(ks[3], (DEC_BATCH, N_MEM, D_MODEL), 1.0),
        'norm_g': 1.0 + nrm(ks[4], (DEPTH, D_MODEL), 0.02),
        'w_in': nrm(ks[5], (DEPTH, D_MODEL, D_IN), D_MODEL ** -0.5),
        'conv_w': nrm(ks[6], (DEPTH, D_CONV, CONV_CH), D_CONV ** -0.5),
        'conv_b': nrm(ks[7], (DEPTH, CONV_CH), 0.02),
        'dt_bias': dt0 + jnp.log(-jnp.expm1(-dt0)),
        'a_log': jnp.log(jax.random.uniform(ks[9], (DEPTH, 2, SSD_HEADS), f32, minval=1.0, maxval=16.0)),
        'd_skip': 1.0 + nrm(ks[10], (DEPTH, SSD_HEADS), 0.02),
        'ssd_norm_g': 1.0 + nrm(ks[11], (DEPTH, SSD_WIDTH), 0.02),
        'q_norm_g': 1.0 + nrm(ks[12], (DEPTH, ATT_HEAD_DIM), 0.02),
        'k_norm_g': 1.0 + nrm(ks[13], (DEPTH, ATT_HEAD_DIM), 0.02),
        'sink': nrm(ks[14], (DEPTH, ATT_HEADS), 0.5),
        'mem_norm_g': 1.0 + nrm(ks[15], (DEPTH, D_MODEL), 0.02),
        'w_mem_kv': nrm(ks[16], (DEPTH, D_MODEL, 2 * MEM_WIDTH), D_MODEL ** -0.5),
        'mq_norm_g': 1.0 + nrm(ks[17], (DEPTH, MEM_HEAD_DIM), 0.02),
        'mk_norm_g': 1.0 + nrm(ks[18], (DEPTH, MEM_HEAD_DIM), 0.02),
        'w_out': nrm(ks[19], (DEPTH, D_MIX, D_MODEL), D_MIX ** -0.5),
    }


def reference(x_prompt, x_sample, mem_prompt, mem_sample, norm_g, w_in, conv_w, conv_b, dt_bias,
              a_log, d_skip, ssd_norm_g, q_norm_g, k_norm_g, sink, mem_norm_g, w_mem_kv,
              mq_norm_g, mk_norm_g, w_out):
    params = (norm_g, w_in, conv_w, conv_b, dt_bias, a_log, d_skip, ssd_norm_g, q_norm_g, k_norm_g,
              sink, mem_norm_g, w_mem_kv, mq_norm_g, mk_norm_g, w_out)
    y_prompt = trunk(x_prompt, mem_prompt, params)
    y_sample = trunk(x_sample, mem_sample, params)
    return (y_prompt, y_sample)
```

```cpp
#include <hip/hip_runtime.h>
#include <hip/hip_cooperative_groups.h>
#include <cstdio>
#include <cstdint>
namespace cg = cooperative_groups;
namespace pg8 {
#define PG8_LAS __attribute__((address_space(3)))
typedef unsigned short bf16_t;
typedef short bf16x8 __attribute__((ext_vector_type(8)));
typedef float f32x4 __attribute__((ext_vector_type(4)));
typedef unsigned u32x4 __attribute__((ext_vector_type(4)));
constexpr int BM = 256, BK = 64, HALF = 128, HTB = HALF * BK * 2  , STAGE_BYTES = 8 * HTB, NXCD = 8, WGM = 8;

__host__ __device__ __forceinline__ int lds_byte(int r, int c) { const int st = (r >> 4) * 2 + (c >> 5), rr = r & 15, cc = c & 31, ob = rr * 64 + cc * 2; return st * 1024 + (ob ^ (((ob >> 9) & 1) << 5)); }
__host__ __device__ __forceinline__ void stage_rc(int b, int& R, int& C) { const int st = b / 1024, sb = b % 1024, swz = sb ^ (((sb >> 9) & 1) << 5); R = (st >> 1) * 16 + swz / 64; C = (st & 1) * 32 + (swz % 64) / 2; }
__host__ __device__ __forceinline__ int perm32(int rho) { const int n = rho >> 4, i = rho & 15; return 8 * (i >> 2) + 4 * n + (i & 3); }

struct Unit { int pm, pn; };
struct Gemm { const bf16_t* A; const bf16_t* Bt; int M, N, K; };

struct StaticOrder {
    int nM, nN, nwg, G, c;
    __host__ __device__ void init(int M, int N, int G_, int c_) { nM = M / BM; nN = N / BM; nwg = nM * nN; G = G_; c = c_; }
    __host__ __device__ bool next(int i, Unit& u) const {
        const long L = (long)i * G + c; if (L >= nwg) return false;
        int wgid = (int)L; { const int q = nwg / NXCD, r = nwg % NXCD, xcd = wgid % NXCD, off = wgid / NXCD; wgid = (xcd < r ? xcd * (q + 1) : r * (q + 1) + (xcd - r) * q) + off; }
        const int nig = WGM * nN, gid = wgid / nig, fm = gid * WGM, gsz = (nM - fm) < WGM ? (nM - fm) : WGM;
        u.pm = fm + ((wgid % nig) % gsz); u.pn = (wgid % nig) / gsz; return true;
    }
    __device__ __forceinline__ void a_ready(const Unit&) const {}
    __device__ __forceinline__ void done(const Unit&) const {}
};

__device__ __forceinline__ unsigned cvt_pk_bf16(float lo, float hi) { unsigned r; asm volatile("v_cvt_pk_bf16_f32 %0, %1, %2" : "=v"(r) : "v"(lo), "v"(hi)); return r; }
template <class Epi, class Sched, bool ALIGN_EPI = false, bool SP2 = false>
__device__ __forceinline__ void gemm_phase(PG8_LAS unsigned char* lds, const Gemm g, const Sched& S, const Epi& E) {
    const int tid = threadIdx.x, wid = __builtin_amdgcn_readfirstlane(tid >> 6), lane = tid & 63, wr = wid >> 2, wc = wid & 3, fr = lane & 15, fq = lane >> 4;
    const int K = g.K, nt = K / BK;
    unsigned voffA[2], voffB[2];
#pragma unroll
    for (int i = 0; i < 2; ++i) { int R, C; stage_rc(tid * 16 + i * 8192, R, C); const int Rb = Epi::PERM ? ((R & ~31) + perm32(R & 31)) : R;
        voffA[i] = (unsigned)(R * K + C) * 2u; voffB[i] = (unsigned)(Rb * K + C) * 2u; }
    const size_t kstep = (size_t)(BK * 2);
    const size_t hstep = (size_t)HALF * K * 2;
    const size_t tstep = 2 * hstep;
    const unsigned ldsw = (unsigned)wid * 1024u;
    const int aoff = lds_byte(wr * 64 + fr, fq * 8), boff = lds_byte(wc * 32 + fr, fq * 8);
#define PG8_SA(b, h) (((b) * 2 + (h)) * HTB)
#define PG8_SB(b, h) ((4 + (b) * 2 + (h)) * HTB)
#define PG8_STAGE(bufoff, gbase, voff) do { _Pragma("unroll") for (int _i = 0; _i < 2; ++_i) \
        __builtin_amdgcn_global_load_lds((const unsigned*)((const char*)(gbase) + (voff)[_i]), (PG8_LAS unsigned*)(lds + (bufoff) + ldsw + _i * 8192), 16, 0, 0); } while (0)
#define PG8_LDA(dst, b, h) do { _Pragma("unroll") for (int m = 0; m < 4; ++m) _Pragma("unroll") for (int k = 0; k < 2; ++k) dst[m][k] = *(const PG8_LAS bf16x8*)(lds + PG8_SA(b, h) + aoff + m * 2048 + k * 1024); } while (0)
#define PG8_LDB(dst, b, h) do { _Pragma("unroll") for (int n = 0; n < 2; ++n) _Pragma("unroll") for (int k = 0; k < 2; ++k) dst[n][k] = *(const PG8_LAS bf16x8*)(lds + PG8_SB(b, h) + boff + n * 2048 + k * 1024); } while (0)
#define PG8_MMA(ai, bj, At, Bt) do { __builtin_amdgcn_s_setprio(1); _Pragma("unroll") for (int m = 0; m < 4; ++m) _Pragma("unroll") for (int n = 0; n < 2; ++n) _Pragma("unroll") for (int k = 0; k < 2; ++k) \
        acc[ai][bj][m][n] = __builtin_amdgcn_mfma_f32_16x16x32_bf16(Bt[n][k], At[m][k], acc[ai][bj][m][n], 0, 0, 0); __builtin_amdgcn_s_setprio(0); } while (0)
#define PG8_WAIT_V(n) asm volatile("s_waitcnt vmcnt(" #n ")" ::: "memory")
#define PG8_WAIT_L(n) asm volatile("s_waitcnt lgkmcnt(" #n ")" ::: "memory")
#define PG8_BAR __builtin_amdgcn_s_barrier()
#define PG8_SCHED __builtin_amdgcn_sched_barrier(0)
    Unit cur, nxt; int ui = 0;
    if (!S.next(0, cur)) return;
    f32x4 acc[2][2][4][2];
#pragma unroll
    for (int a = 0; a < 2; ++a)
#pragma unroll
        for (int b = 0; b < 2; ++b)
#pragma unroll
            for (int m = 0; m < 4; ++m)
#pragma unroll
                for (int n = 0; n < 2; ++n) acc[a][b][m][n] = (f32x4){0.f, 0.f, 0.f, 0.f};
    bf16x8 At[4][2], B0[2][2], B1[2][2];
    const char* cA = (const char*)g.A + (size_t)cur.pm * tstep; const char* cB = (const char*)g.Bt + (size_t)cur.pn * tstep;
    S.a_ready(cur);
    if constexpr (SP2) {
        PG8_STAGE(PG8_SB(0, 0), cB, voffB); PG8_STAGE(PG8_SB(0, 1), cB + hstep, voffB); PG8_STAGE(PG8_SA(0, 0), cA, voffA); PG8_STAGE(PG8_SA(0, 1), cA + hstep, voffA);
        if (wr == 1) PG8_BAR;
        PG8_WAIT_V(2); PG8_BAR;
        PG8_STAGE(PG8_SB(1, 0), cB + kstep, voffB); PG8_STAGE(PG8_SA(1, 0), cA + kstep, voffA); PG8_STAGE(PG8_SB(1, 1), cB + hstep + kstep, voffB);
        PG8_WAIT_V(6); PG8_BAR;
    } else {
        PG8_STAGE(PG8_SB(0, 0), cB, voffB); PG8_STAGE(PG8_SA(0, 0), cA, voffA); PG8_STAGE(PG8_SB(0, 1), cB + hstep, voffB); PG8_STAGE(PG8_SA(0, 1), cA + hstep, voffA);
        if (wr == 1) PG8_BAR;
        PG8_WAIT_V(4); PG8_BAR;
        PG8_STAGE(PG8_SB(1, 0), cB + kstep, voffB); PG8_STAGE(PG8_SA(1, 0), cA + kstep, voffA); PG8_STAGE(PG8_SB(1, 1), cB + hstep + kstep, voffB);
        PG8_WAIT_V(6); PG8_BAR;
    }
    for (;;) {
        const bool has_next = S.next(ui + 1, nxt);
        const char* nA = has_next ? (const char*)g.A + (size_t)nxt.pm * tstep : cA; const char* nB = has_next ? (const char*)g.Bt + (size_t)nxt.pn * tstep : cB;
        for (int t = 0; t < nt; t += 2) {
            const bool last = (t == nt - 2);
            const char* a1 = cA + (size_t)(t + 1) * kstep;
            const char* a2 = last ? nA : cA + (size_t)(t + 2) * kstep; const char* b2 = last ? nB : cB + (size_t)(t + 2) * kstep;
            const char* a3 = a2 + kstep; const char* b3 = b2 + kstep;
            if (last && has_next) S.a_ready(nxt);
            if constexpr (SP2) {
            PG8_LDB(B0, 0, 0); PG8_LDB(B1, 0, 1); PG8_SCHED; PG8_LDA(At, 0, 0); PG8_STAGE(PG8_SA(1, 1), a1 + hstep, voffA);
            PG8_WAIT_V(8); PG8_WAIT_L(0); PG8_BAR; PG8_MMA(0, 0, At, B0); PG8_MMA(0, 1, At, B1); PG8_BAR; PG8_SCHED;
            PG8_LDA(At, 0, 1); PG8_STAGE(PG8_SB(0, 0), b2, voffB); PG8_STAGE(PG8_SB(0, 1), b2 + hstep, voffB); PG8_STAGE(PG8_SA(0, 0), a2, voffA);
            PG8_WAIT_V(8); PG8_WAIT_L(0); PG8_BAR; PG8_MMA(1, 0, At, B0); PG8_MMA(1, 1, At, B1); PG8_BAR; PG8_SCHED;
            PG8_LDB(B0, 1, 0); PG8_LDB(B1, 1, 1); PG8_SCHED; PG8_LDA(At, 1, 0); PG8_STAGE(PG8_SA(0, 1), a2 + hstep, voffA);
            PG8_WAIT_V(8); PG8_WAIT_L(0); PG8_BAR; PG8_MMA(0, 0, At, B0); PG8_MMA(0, 1, At, B1); PG8_BAR; PG8_SCHED;
            PG8_LDA(At, 1, 1); PG8_STAGE(PG8_SB(1, 0), b3, voffB); PG8_STAGE(PG8_SB(1, 1), b3 + hstep, voffB); PG8_STAGE(PG8_SA(1, 0), a3, voffA);
            PG8_WAIT_V(8); PG8_WAIT_L(0); PG8_BAR; PG8_MMA(1, 0, At, B0); PG8_MMA(1, 1, At, B1); PG8_BAR; PG8_SCHED;
            } else {
            PG8_LDB(B0, 0, 0); PG8_SCHED; PG8_LDA(At, 0, 0); PG8_STAGE(PG8_SA(1, 1), a1 + hstep, voffA);
            PG8_WAIT_L(8); PG8_BAR; PG8_WAIT_L(0); PG8_MMA(0, 0, At, B0); PG8_BAR; PG8_SCHED;
            PG8_LDB(B1, 0, 1); PG8_STAGE(PG8_SB(0, 0), b2, voffB);
            PG8_BAR; PG8_WAIT_L(0); PG8_MMA(0, 1, At, B1); PG8_BAR;
            PG8_LDA(At, 0, 1); PG8_STAGE(PG8_SA(0, 0), a2, voffA);
            PG8_BAR; PG8_WAIT_L(0); PG8_MMA(1, 0, At, B0); PG8_BAR; PG8_SCHED;
            PG8_STAGE(PG8_SB(0, 1), b2 + hstep, voffB);
            PG8_WAIT_V(6); PG8_BAR; PG8_MMA(1, 1, At, B1); PG8_BAR;
            PG8_LDB(B0, 1, 0); PG8_SCHED; PG8_LDA(At, 1, 0); PG8_STAGE(PG8_SA(0, 1), a2 + hstep, voffA);
            PG8_WAIT_L(8); PG8_BAR; PG8_WAIT_L(0); PG8_MMA(0, 0, At, B0); PG8_BAR; PG8_SCHED;
            PG8_LDB(B1, 1, 1); PG8_STAGE(PG8_SB(1, 0), b3, voffB);
            PG8_BAR; PG8_WAIT_L(0); PG8_MMA(0, 1, At, B1); PG8_BAR;
            PG8_LDA(At, 1, 1); PG8_STAGE(PG8_SA(1, 0), a3, voffA);
            PG8_BAR; PG8_WAIT_L(0); PG8_MMA(1, 0, At, B0); PG8_BAR; PG8_SCHED;
            PG8_STAGE(PG8_SB(1, 1), b3 + hstep, voffB);
            PG8_WAIT_V(6); PG8_BAR; PG8_MMA(1, 1, At, B1); PG8_BAR;
            }
        }
        if constexpr (ALIGN_EPI) { if (wr == 0) PG8_BAR; }
        if constexpr (!Epi::AFTER_DRAIN) { E(acc, cur, wr, wc, fr, fq); S.done(cur); }
        if (!has_next) break;
#pragma unroll
        for (int a = 0; a < 2; ++a)
#pragma unroll
            for (int b = 0; b < 2; ++b)
#pragma unroll
                for (int m = 0; m < 4; ++m)
#pragma unroll
                    for (int n = 0; n < 2; ++n) acc[a][b][m][n] = (f32x4){0.f, 0.f, 0.f, 0.f};
        cur = nxt; cA = nA; cB = nB; ++ui;
        if constexpr (ALIGN_EPI) { if (wr == 1) PG8_BAR; }
    }
    PG8_WAIT_V(0);
    if constexpr (!ALIGN_EPI) { if (wr == 0) PG8_BAR; }
    PG8_BAR;
    if constexpr (Epi::AFTER_DRAIN) { E.fused(acc, cur, wr, wc, fr, fq, lds, wid, lane); S.done(cur); }
#undef PG8_SA
#undef PG8_SB
#undef PG8_STAGE
#undef PG8_LDA
#undef PG8_LDB
#undef PG8_MMA
#undef PG8_WAIT_V
#undef PG8_WAIT_L
#undef PG8_BAR
#undef PG8_SCHED
}
}

#define LAS __attribute__((address_space(3)))
typedef unsigned short bf16;
typedef unsigned v4u __attribute__((ext_vector_type(4)));
typedef unsigned v2u __attribute__((ext_vector_type(2)));
typedef float f32x4 __attribute__((ext_vector_type(4)));
typedef short bf16x8 __attribute__((ext_vector_type(8)));
constexpr int DM = 2048, MTOT = 40960, MPROMPT = 8192, DIN = 4896, DINP = 5120, PLD = 4928  , NCHUNKS = 320;
constexpr int C_ZSSD = 1536, C_DT = 2560, C_Q = 2592, C_K = 3104, C_V = 3232, C_ZATT = 3360, C_MQ = 3872, C_ZMEM = 4384;
constexpr float EPS = 1e-6f;
constexpr size_t MiB = 1u << 20;
constexpr size_t WS_WIN = 2 * MiB, WS_WOUT = 22 * MiB, WS_WMEM = 30 * MiB, WS_MEMN = 34 * MiB, WS_MKV = 42 * MiB, WS_DT = 46 * MiB, WS_CD = 51 * MiB,
                 WS_BN = 52 * MiB, WS_CN = 72 * MiB, WS_XT = 92 * MiB, WS_ST = 172 * MiB, WS_CC = 332 * MiB, WS_PROJ = 492 * MiB, WS_END = 878 * MiB;
constexpr size_t OUT_XN = 0, OUT_SP = 160 * MiB;
constexpr size_t WS_BAR = 65536, WS_CTL_BYTES = 131072;
constexpr int LDS_BYTES = 147456;
#ifndef EXPT
#define EXPT 0
#endif
#ifndef DUPMASK
#define DUPMASK 0
#endif
#ifndef GEMM_ALIGN
#define GEMM_ALIGN true
#endif

struct Params {
    const float *x_prompt, *x_sample, *mem_prompt, *mem_sample, *norm_g, *w_in, *conv_w, *conv_b, *dt_bias, *a_log, *d_skip, *ssd_norm_g, *q_norm_g, *k_norm_g, *sink,
                *mem_norm_g, *w_mem_kv, *mq_norm_g, *mk_norm_g, *w_out;
    float* out; unsigned char* ws;
};

__device__ __forceinline__ float bf_lo(unsigned u) { return __uint_as_float(u << 16); }
__device__ __forceinline__ float bf_hi(unsigned u) { return __uint_as_float(u & 0xffff0000u); }
__device__ __forceinline__ float bf1(bf16 v) { return __uint_as_float((unsigned)v << 16); }
typedef float f32x2_t __attribute__((ext_vector_type(2))); typedef __bf16 bf16x2_t __attribute__((ext_vector_type(2)));
__device__ __forceinline__ unsigned pk2(float lo, float hi) { f32x2_t v = {lo, hi}; bf16x2_t b = __builtin_convertvector(v, bf16x2_t); return __builtin_bit_cast(unsigned, b); }
__device__ __forceinline__ bf16 f2bf(float f) { return (bf16)(pk2(f, 0.f) & 0xffffu); }
__device__ __forceinline__ float silu(float v) { return v / (1.f + __expf(-v)); }
__device__ __forceinline__ float softplus(float v) { return fmaxf(v, 0.f) + log1pf(__expf(-fabsf(v))); }
__device__ __forceinline__ void unpack8(v4u r, float* f) { f[0] = bf_lo(r.x); f[1] = bf_hi(r.x); f[2] = bf_lo(r.y); f[3] = bf_hi(r.y); f[4] = bf_lo(r.z); f[5] = bf_hi(r.z); f[6] = bf_lo(r.w); f[7] = bf_hi(r.w); }
__device__ __forceinline__ v4u pack8(const float* f) { v4u r; r.x = pk2(f[0], f[1]); r.y = pk2(f[2], f[3]); r.z = pk2(f[4], f[5]); r.w = pk2(f[6], f[7]); return r; }
__device__ __forceinline__ bf16x8 as_frag(v4u r) { return __builtin_bit_cast(bf16x8, r); }
__device__ __forceinline__ f32x4 mfma16(bf16x8 a, bf16x8 b, f32x4 c) { return __builtin_amdgcn_mfma_f32_16x16x32_bf16(a, b, c, 0, 0, 0); }
__device__ __forceinline__ float wave_sum(float v) {
#pragma unroll
    for (int o = 1; o < 64; o <<= 1) v += __shfl_xor(v, o);
    return v;
}
__device__ __forceinline__ float wave_incl_scan(float v, int lane, LAS float* sc, float& tot) {
    sc[lane] = v; asm volatile("s_waitcnt lgkmcnt(0)" ::: "memory");
    float s = 0.f, t = 0.f;
#pragma unroll 8
    for (int k = 0; k < 64; ++k) { const float x = sc[k]; t += x; s += (k <= lane) ? x : 0.f; }
    asm volatile("s_waitcnt lgkmcnt(0)" ::: "memory");
    tot = t; return s;
}
__device__ __forceinline__ void chunk_info(int cgi, int& T, int& t0, int& bg) {
    if (cgi < 64) { T = 2048; t0 = (cgi & 15) * 128; bg = cgi >> 4; } else { const int q = cgi - 64; T = 8192; t0 = (q & 63) * 128; bg = 4 + (q >> 6); }
}
__device__ __forceinline__ int prow(int r) { return r + (r >> 3); }

__device__ __forceinline__ void p0_transpose_item(const float* W, int K, int N, bf16* WT, LAS float* scr, int item, int lane) {
    const int nblk = N / 32, kb = item / nblk, nb = item % nblk, k0 = 64 * kb, n0 = 32 * nb;
    float tv[32];
#pragma unroll
    for (int i = 0; i < 32; ++i) tv[i] = W[(size_t)(k0 + 2 * i + (lane >> 5)) * N + n0 + (lane & 31)];
#pragma unroll
    for (int i = 0; i < 32; ++i) scr[(2 * i + (lane >> 5)) * 33 + (lane & 31)] = tv[i];
    asm volatile("s_waitcnt lgkmcnt(0)" ::: "memory");
    const int c = lane & 7;
#pragma unroll
    for (int j = 0; j < 4; ++j) { const int n = (lane >> 3) + 8 * j; const LAS float* s = scr + (8 * c) * 33 + n;
        v4u o; o.x = pk2(s[0 * 33], s[1 * 33]); o.y = pk2(s[2 * 33], s[3 * 33]); o.z = pk2(s[4 * 33], s[5 * 33]); o.w = pk2(s[6 * 33], s[7 * 33]);
        *(v4u*)(WT + (size_t)(n0 + n) * K + k0 + 8 * c) = o; }
    asm volatile("s_waitcnt lgkmcnt(0)" ::: "memory");
}
template <int NR> __device__ __forceinline__ void rms_rows_to_bf16(const float* const (&xrow)[NR], const float* g, bf16* const (&orow)[NR], int lane) {
    f32x4 v[NR][8];
#pragma unroll
    for (int r = 0; r < NR; ++r) { const f32x4* xr = (const f32x4*)xrow[r] + lane;
#pragma unroll
        for (int j = 0; j < 8; ++j) v[r][j] = xr[64 * j]; }
    const f32x4* gr = (const f32x4*)g + lane;
#pragma unroll
    for (int r = 0; r < NR; ++r) { float s = 0.f;
#pragma unroll
        for (int j = 0; j < 8; ++j) s += (v[r][j].x * v[r][j].x + v[r][j].y * v[r][j].y) + (v[r][j].z * v[r][j].z + v[r][j].w * v[r][j].w);
        const float rstd = rsqrtf(wave_sum(s) * (1.f / DM) + EPS);
        v2u* o8 = (v2u*)orow[r] + lane;
#pragma unroll
        for (int j = 0; j < 8; ++j) { const f32x4 gg = gr[64 * j]; v2u o; o.x = pk2(v[r][j].x * rstd * gg.x, v[r][j].y * rstd * gg.y); o.y = pk2(v[r][j].z * rstd * gg.z, v[r][j].w * rstd * gg.w); o8[64 * j] = o; } }
}
__device__ __forceinline__ void p0_prologue(LAS unsigned char* lds, const Params& P) {
    const int tid = threadIdx.x, lane = tid & 63, wave = tid >> 6;
    LAS float* scr = (LAS float*)(lds + wave * 16384);
    const int gw = blockIdx.x * 8 + wave, NGW = gridDim.x * 8;
    bf16* WinT = (bf16*)(P.ws + WS_WIN); bf16* WoutT = (bf16*)(P.ws + WS_WOUT); bf16* WmemT = (bf16*)(P.ws + WS_WMEM);
    constexpr int I_IN = 32 * (DIN / 32), I_OUT = 32 * (DM / 32), I_MEM = 32 * (1024 / 32);
    for (int it = gw; it < I_IN + I_OUT + I_MEM; it += NGW) {
        int r = it;
        if (r < I_IN) { p0_transpose_item(P.w_in, DM, DIN, WinT, scr, r, lane); continue; } r -= I_IN;
        if (r < I_OUT) { p0_transpose_item(P.w_out, DM, DM, WoutT, scr, r, lane); continue; } r -= I_OUT;
        p0_transpose_item(P.w_mem_kv, DM, 1024, WmemT, scr, r, lane);
    }
    { v4u* z = (v4u*)(WinT + (size_t)DIN * DM); const int nz = (DINP - DIN) * DM / 8; const v4u zero = {0u, 0u, 0u, 0u};
      for (int i = blockIdx.x * 512 + tid; i < nz; i += gridDim.x * 512) z[i] = zero; }
    bf16* XN = (bf16*)((unsigned char*)P.out + OUT_XN); bf16* MEMN = (bf16*)(P.ws + WS_MEMN);
    for (int m4 = gw; m4 < (MTOT + 2048) / 4; m4 += NGW) {
        const int m = m4 * 4; const float* src; const float* gain; bf16* dst;
        if (m < MPROMPT) { src = P.x_prompt + (size_t)m * DM; gain = P.norm_g; dst = XN + (size_t)m * DM; }
        else if (m < MTOT) { src = P.x_sample + (size_t)(m - MPROMPT) * DM; gain = P.norm_g; dst = XN + (size_t)m * DM; }
        else { const int r = m - MTOT; src = r < 1024 ? P.mem_prompt + (size_t)r * DM : P.mem_sample + (size_t)(r - 1024) * DM; gain = P.mem_norm_g; dst = MEMN + (size_t)r * DM; }
        const float* const xr[4] = {src, src + DM, src + 2 * DM, src + 3 * DM}; bf16* const orr[4] = {dst, dst + DM, dst + 2 * DM, dst + 3 * DM};
        rms_rows_to_bf16<4>(xr, gain, orr, lane);
    }
}

struct EpiProj {
    static constexpr bool PERM = true, AFTER_DRAIN = false;
    bf16* O; float* DT;
    __device__ __forceinline__ void operator()(const pg8::f32x4 (&acc)[2][2][4][2], const pg8::Unit& u, int wr, int wc, int fr, int fq) const {
        const int row0 = u.pm * 256 + wr * 64 + fr, col0 = u.pn * 256 + wc * 32 + 8 * fq;
#pragma unroll
        for (int ai = 0; ai < 2; ++ai)
#pragma unroll
            for (int m = 0; m < 4; ++m) { const size_t row = (size_t)(row0 + ai * 128 + m * 16);
#pragma unroll
                for (int bj = 0; bj < 2; ++bj) { const int col = col0 + bj * 128; if (col >= DIN) continue;
                    const pg8::f32x4 v0 = acc[ai][bj][m][0], v1 = acc[ai][bj][m][1];
                    v4u w; w.x = pk2(v0[0], v0[1]); w.y = pk2(v0[2], v0[3]); w.z = pk2(v1[0], v1[1]); w.w = pk2(v1[2], v1[3]);
                    *(v4u*)(O + row * PLD + col) = w;
                    if (col >= C_DT && col < C_DT + 32) { float* d = DT + row * 32 + (col - C_DT); *(f32x4*)d = v0; *(f32x4*)(d + 4) = v1; } } }
    }
};
struct EpiPlain {
    static constexpr bool PERM = true, AFTER_DRAIN = false;
    bf16* O; int ldc;
    __device__ __forceinline__ void operator()(const pg8::f32x4 (&acc)[2][2][4][2], const pg8::Unit& u, int wr, int wc, int fr, int fq) const {
        const int row0 = u.pm * 256 + wr * 64 + fr, col0 = u.pn * 256 + wc * 32 + 8 * fq;
#pragma unroll
        for (int ai = 0; ai < 2; ++ai)
#pragma unroll
            for (int m = 0; m < 4; ++m) { const size_t row = (size_t)(row0 + ai * 128 + m * 16);
#pragma unroll
                for (int bj = 0; bj < 2; ++bj) { const int col = col0 + bj * 128;
                    const pg8::f32x4 v0 = acc[ai][bj][m][0], v1 = acc[ai][bj][m][1];
                    v4u w; w.x = pk2(v0[0], v0[1]); w.y = pk2(v0[2], v0[3]); w.z = pk2(v1[0], v1[1]); w.w = pk2(v1[2], v1[3]);
                    *(v4u*)(O + row * ldc + col) = w; } }
    }
};
struct EpiOut {
    static constexpr bool PERM = false, AFTER_DRAIN = false;
    const float* xp; const float* xs; float* out;
    __device__ __forceinline__ void operator()(const pg8::f32x4 (&acc)[2][2][4][2], const pg8::Unit& u, int wr, int wc, int fr, int fq) const {
        const int row0 = u.pm * 256 + wr * 64 + fr, col0 = u.pn * 256 + wc * 32 + 4 * fq;
        const float* xb = (u.pm < MPROMPT / 256) ? xp : xs - (size_t)MPROMPT * DM;
#pragma unroll
        for (int ai = 0; ai < 2; ++ai)
#pragma unroll
            for (int m = 0; m < 4; ++m) { const size_t off = (size_t)(row0 + ai * 128 + m * 16) * DM + col0;
#pragma unroll
                for (int bj = 0; bj < 2; ++bj)
#pragma unroll
                    for (int n = 0; n < 2; ++n) { const pg8::f32x4 xv = *(const pg8::f32x4*)(xb + off + bj * 128 + n * 16); *(pg8::f32x4*)(out + off + bj * 128 + n * 16) = xv + acc[ai][bj][m][n]; } }
    }
};
struct MemOrder {
    int c, G;
    __device__ bool next(int i, pg8::Unit& u) const { const int cc = (c + G - (128 % G)) % G; const int k = i * G + cc; if (k >= 32) return false; u.pm = k >> 2; u.pn = k & 3; return true; }
    __device__ __forceinline__ void a_ready(const pg8::Unit&) const {}
    __device__ __forceinline__ void done(const pg8::Unit&) const {}
};

__device__ __forceinline__ void conv_run4(const bf16* PROJ, const float* cw, const float* cb, int m0, int t0, int T, int j0, int ch0, bool to_img, LAS bf16* img, int row0, bf16* nat) {
    unsigned xr[8][4];
#pragma unroll
    for (int r = 0; r < 8; ++r) { const int t = t0 + j0 - 2 + r; v4u raw = {0u, 0u, 0u, 0u}; if (t >= 0 && t < T) raw = *(const v4u*)(PROJ + (size_t)(m0 + j0 - 2 + r) * PLD + ch0);
        xr[r][0] = raw.x; xr[r][1] = raw.y; xr[r][2] = raw.z; xr[r][3] = raw.w; }
    unsigned res[4][4];
    float wt[5][8], bs[8];
#pragma unroll
    for (int k = 0; k < 5; ++k) { const f32x4 w0 = *(const f32x4*)(cw + k * 1536 + ch0), w1 = *(const f32x4*)(cw + k * 1536 + ch0 + 4);
        wt[k][0] = w0.x; wt[k][1] = w0.y; wt[k][2] = w0.z; wt[k][3] = w0.w; wt[k][4] = w1.x; wt[k][5] = w1.y; wt[k][6] = w1.z; wt[k][7] = w1.w; }
    { const f32x4 b0 = *(const f32x4*)(cb + ch0), b1 = *(const f32x4*)(cb + ch0 + 4); bs[0] = b0.x; bs[1] = b0.y; bs[2] = b0.z; bs[3] = b0.w; bs[4] = b1.x; bs[5] = b1.y; bs[6] = b1.z; bs[7] = b1.w; }
#pragma unroll
    for (int cp = 0; cp < 4; ++cp) {
        float wl[5], wh[5];
#pragma unroll
        for (int k = 0; k < 5; ++k) { wl[k] = wt[k][2 * cp]; wh[k] = wt[k][2 * cp + 1]; }
        const float bl = bs[2 * cp], bh = bs[2 * cp + 1];
        float al[4], ah[4];
#pragma unroll
        for (int tk = 0; tk < 4; ++tk) { al[tk] = bl; ah[tk] = bh; }
#pragma unroll
        for (int r = 0; r < 8; ++r) { const float xl = bf_lo(xr[r][cp]), xh = bf_hi(xr[r][cp]);
#pragma unroll
            for (int k = 0; k < 5; ++k) { const int tk = r - k; if (tk >= 0 && tk < 4) { al[tk] += wl[k] * xl; ah[tk] += wh[k] * xh; } } }
#pragma unroll
        for (int tk = 0; tk < 4; ++tk) { al[tk] = silu(al[tk]); ah[tk] = silu(ah[tk]); res[tk][cp] = pk2(al[tk], ah[tk]); }
        if (to_img) {
            v2u o; o.x = pk2(al[0], al[1]); o.y = pk2(al[2], al[3]); *(LAS v2u*)(img + prow(row0 + 2 * cp) * 136 + j0) = o;
            o.x = pk2(ah[0], ah[1]); o.y = pk2(ah[2], ah[3]); *(LAS v2u*)(img + prow(row0 + 2 * cp + 1) * 136 + j0) = o;
        }
        __builtin_amdgcn_sched_barrier(0);
    }
    if (nat) {
#pragma unroll
        for (int tk = 0; tk < 4; ++tk) { v4u o; o.x = res[tk][0]; o.y = res[tk][1]; o.z = res[tk][2]; o.w = res[tk][3]; *(v4u*)(nat + tk * 256) = o; }
    }
}
constexpr int TS = 136;
__device__ __forceinline__ void ssd_state_item(LAS unsigned char* lds, const Params& P, int item) {
    const int tid = threadIdx.x, lane = tid & 63, w = tid >> 6, fr = lane & 15, fq = lane >> 4;
    const int cgi = item >> 2, g = (item >> 1) & 1, hq = item & 1;
    int T, t0, bg; chunk_info(cgi, T, t0, bg);
    const int m0 = cgi * 128;
    const bf16* PROJ = (const bf16*)(P.ws + WS_PROJ); const float* DT = (const float*)(P.ws + WS_DT); float* CD = (float*)(P.ws + WS_CD);
    bf16* BN = (bf16*)(P.ws + WS_BN); bf16* CN = (bf16*)(P.ws + WS_CN); bf16* XTg = (bf16*)(P.ws + WS_XT); bf16* ST = (bf16*)(P.ws + WS_ST);
    LAS bf16* XT = (LAS bf16*)lds;
    LAS bf16* BT = XT + 288 * TS;
    LAS float* WF = (LAS float*)(BT + 144 * TS);
    {
        const int dir = w >> 2, hh = w & 3, head = g * 8 + hq * 4 + hh;
        const float bias = P.dt_bias[dir * 16 + head], A = -__expf(P.a_log[dir * 16 + head]);
        const float r0 = DT[(size_t)(m0 + 2 * lane) * 32 + dir * 16 + head], r1 = DT[(size_t)(m0 + 2 * lane + 1) * 32 + dir * 16 + head];
        const float d0 = softplus(r0 + bias), d1 = softplus(r1 + bias), a0 = d0 * A, a1 = d1 * A;
        float tot; const float inc = wave_incl_scan(a0 + a1, lane, WF + 1024 + w * 64, tot);
        const float p1 = inc, p0 = inc - a1;
        float w0, w1;
        if (dir == 0) { w0 = d0 * __expf(tot - p0); w1 = d1 * __expf(tot - p1); }
        else { w0 = d0 * __expf(p0 - a0); w1 = d1 * __expf(p1 - a1); }
        WF[(dir * 4 + hh) * 128 + 2 * lane] = w0; WF[(dir * 4 + hh) * 128 + 2 * lane + 1] = w1;
        if (lane == 0) CD[item * 32 + dir * 4 + hh] = __expf(tot);
    }
#pragma unroll 1
    for (int rnd = 0; rnd < 3 + hq; ++rnd) {
        const bool isx = rnd < 2;
        const int c8 = isx ? (tid & 31) : (tid & 15), j0 = (isx ? (tid >> 5) + 16 * rnd : (tid >> 4)) * 4;
        const int ch0 = isx ? g * 512 + hq * 256 + c8 * 8 : 1024 + (rnd - 2) * 256 + g * 128 + c8 * 8;
        LAS bf16* img = isx ? XT : BT;
        bf16* nat = isx ? (bf16*)nullptr : (rnd == 2 ? (hq == 0 ? BN + (size_t)(m0 + j0) * 256 + g * 128 + c8 * 8 : (bf16*)nullptr) : CN + (size_t)(m0 + j0) * 256 + g * 128 + c8 * 8);
        conv_run4(PROJ, P.conv_w, P.conv_b, m0, t0, T, j0, ch0, rnd < 3, img, c8 * 8, nat);
    }
    __syncthreads();
    for (int q = tid; q < 4096; q += 512) { const int j8 = q & 15, r = q >> 4;
        *(v4u*)(XTg + ((size_t)cgi * 1024 + g * 512 + hq * 256 + r) * 128 + j8 * 8) = *(const LAS v4u*)(XT + prow(r) * TS + j8 * 8); }
    const int hh = w >> 1, dir = w & 1, head = g * 8 + hq * 4 + hh;
    bf16* sp = ST + ((size_t)(cgi * 2 + dir) * 16 + head) * 8192;
#pragma unroll 1
    for (int nh = 0; nh < 2; ++nh) {
        f32x4 acc[4][4];
#pragma unroll
        for (int a = 0; a < 4; ++a)
#pragma unroll
            for (int b = 0; b < 4; ++b) acc[a][b] = (f32x4){0.f, 0.f, 0.f, 0.f};
#pragma unroll 1
        for (int ks = 0; ks < 4; ++ks) {
            const int jb = ks * 32 + 8 * fq;
            bf16x8 bfr[4];
#pragma unroll
            for (int nt = 0; nt < 4; ++nt) bfr[nt] = as_frag(*(const LAS v4u*)(BT + prow(nh * 64 + nt * 16 + fr) * TS + jb));
            float wv[8];
            { const f32x4 a = *(const LAS f32x4*)(WF + (dir * 4 + hh) * 128 + jb), b = *(const LAS f32x4*)(WF + (dir * 4 + hh) * 128 + jb + 4);
              wv[0] = a.x; wv[1] = a.y; wv[2] = a.z; wv[3] = a.w; wv[4] = b.x; wv[5] = b.y; wv[6] = b.z; wv[7] = b.w; }
#pragma unroll
            for (int pt = 0; pt < 4; ++pt) {
                float xv[8]; unpack8(*(const LAS v4u*)(XT + prow(hh * 64 + pt * 16 + fr) * TS + jb), xv);
#pragma unroll
                for (int e = 0; e < 8; ++e) xv[e] *= wv[e];
                const bf16x8 af = as_frag(pack8(xv));
#pragma unroll
                for (int nt = 0; nt < 4; ++nt) acc[pt][nt] = mfma16(bfr[nt], af, acc[pt][nt]);
            }
        }
#pragma unroll
        for (int pt = 0; pt < 4; ++pt)
#pragma unroll
            for (int nt = 0; nt < 4; ++nt) { v2u o; o.x = pk2(acc[pt][nt][0], acc[pt][nt][1]); o.y = pk2(acc[pt][nt][2], acc[pt][nt][3]);
                *(v2u*)(sp + (pt * 16 + fr) * 128 + nh * 64 + nt * 16 + 4 * fq) = o; }
    }
    __syncthreads();
}

__device__ __forceinline__ void transpose8x8_bf16(const v4u (&in)[8], v4u (&out)[8]) {
#pragma unroll
    for (int c2 = 0; c2 < 4; ++c2) {
        unsigned r[8];
#pragma unroll
        for (int k = 0; k < 8; ++k) r[k] = c2 == 0 ? in[k].x : (c2 == 1 ? in[k].y : (c2 == 2 ? in[k].z : in[k].w));
        v4u lo, hi;
        lo.x = __builtin_amdgcn_perm(r[1], r[0], 0x05040100u); lo.y = __builtin_amdgcn_perm(r[3], r[2], 0x05040100u); lo.z = __builtin_amdgcn_perm(r[5], r[4], 0x05040100u); lo.w = __builtin_amdgcn_perm(r[7], r[6], 0x05040100u);
        hi.x = __builtin_amdgcn_perm(r[1], r[0], 0x07060302u); hi.y = __builtin_amdgcn_perm(r[3], r[2], 0x07060302u); hi.z = __builtin_amdgcn_perm(r[5], r[4], 0x07060302u); hi.w = __builtin_amdgcn_perm(r[7], r[6], 0x07060302u);
        out[2 * c2] = lo; out[2 * c2 + 1] = hi;
    }
}
constexpr int WK_ROWS = 416, WK_S = 72, WV_S = 424;
__device__ __forceinline__ void win_attn_item(LAS unsigned char* lds, const Params& P, int item) {
    const int tid = threadIdx.x, lane = tid & 63, w = tid >> 6, fr = lane & 15, fq = lane >> 4;
    const int cgi = item >> 1, kvh = item & 1;
    int T, t0, bg; chunk_info(cgi, T, t0, bg);
    const int m0 = cgi * 128;
    const bf16* PROJ = (const bf16*)(P.ws + WS_PROJ); bf16* CC = (bf16*)(P.ws + WS_CC);
    LAS bf16* Ks = (LAS bf16*)lds;
    LAS bf16* VT = Ks + WK_ROWS * WK_S;
    if (tid < 416) {
        const int ch = tid & 7, j0 = (tid >> 3) * 8;
        const f32x4 g0 = *(const f32x4*)(P.k_norm_g + ch * 8), g1 = *(const f32x4*)(P.k_norm_g + ch * 8 + 4);
        v4u kin[8], vin[8], vout[8];
#pragma unroll
        for (int k = 0; k < 8; ++k) { const int jj = j0 + k, t = t0 - 128 + jj; const bool ok = (jj < 384) && (t >= 0) && (t < T);
            kin[k] = (v4u){0u, 0u, 0u, 0u}; vin[k] = (v4u){0u, 0u, 0u, 0u};
            if (ok) { const bf16* rowp = PROJ + (size_t)(m0 - 128 + jj) * PLD; kin[k] = *(const v4u*)(rowp + C_K + kvh * 64 + ch * 8); vin[k] = *(const v4u*)(rowp + C_V + kvh * 64 + ch * 8); } }
        __builtin_amdgcn_sched_barrier(0);
#pragma unroll
        for (int k = 0; k < 8; ++k) { const int jj = j0 + k; float kv[8];
            unpack8(kin[k], kv);
            float ss = 0.f;
#pragma unroll
            for (int e = 0; e < 8; ++e) ss += kv[e] * kv[e];
            ss += __shfl_xor(ss, 1); ss += __shfl_xor(ss, 2); ss += __shfl_xor(ss, 4);
            const float rstd = rsqrtf(ss * (1.f / 64.f) + EPS);
            kv[0] *= rstd * g0.x; kv[1] *= rstd * g0.y; kv[2] *= rstd * g0.z; kv[3] *= rstd * g0.w; kv[4] *= rstd * g1.x; kv[5] *= rstd * g1.y; kv[6] *= rstd * g1.z; kv[7] *= rstd * g1.w;
            *(LAS v4u*)(Ks + jj * WK_S + ch * 8) = pack8(kv); }
        transpose8x8_bf16(vin, vout);
#pragma unroll
        for (int e = 0; e < 8; ++e) *(LAS v4u*)(VT + prow(ch * 8 + e) * WV_S + j0) = vout[e];
    }
    __syncthreads();
    const int hh = w >> 1, half = w & 1, H = kvh * 4 + hh;
    const float slope = exp2f(-(float)(H + 1)), sink = P.sink[H];
    for (int qt = 0; qt < 4; ++qt) {
        const int i0 = half * 64 + qt * 16;
        bf16x8 qf[2];
        { float q0[8], q1[8]; const bf16* qp = PROJ + (size_t)(m0 + i0 + fr) * PLD + C_Q + H * 64 + 8 * fq;
          unpack8(*(const v4u*)qp, q0); unpack8(*(const v4u*)(qp + 32), q1);
          float ss = 0.f;
#pragma unroll
          for (int e = 0; e < 8; ++e) ss += q0[e] * q0[e] + q1[e] * q1[e];
          ss += __shfl_xor(ss, 16); ss += __shfl_xor(ss, 32);
          const float sc = rsqrtf(ss * (1.f / 64.f) + EPS) * 0.125f;
          const f32x4 ga = *(const f32x4*)(P.q_norm_g + 8 * fq), gb = *(const f32x4*)(P.q_norm_g + 8 * fq + 4), gc = *(const f32x4*)(P.q_norm_g + 32 + 8 * fq), gd = *(const f32x4*)(P.q_norm_g + 32 + 8 * fq + 4);
          q0[0] *= sc * ga.x; q0[1] *= sc * ga.y; q0[2] *= sc * ga.z; q0[3] *= sc * ga.w; q0[4] *= sc * gb.x; q0[5] *= sc * gb.y; q0[6] *= sc * gb.z; q0[7] *= sc * gb.w;
          q1[0] *= sc * gc.x; q1[1] *= sc * gc.y; q1[2] *= sc * gc.z; q1[3] *= sc * gc.w; q1[4] *= sc * gd.x; q1[5] *= sc * gd.y; q1[6] *= sc * gd.z; q1[7] *= sc * gd.w;
          qf[0] = as_frag(pack8(q0)); qf[1] = as_frag(pack8(q1)); }
        f32x4 st[18];
#pragma unroll
        for (int kt = 0; kt < 18; ++kt) {
            f32x4 a = {0.f, 0.f, 0.f, 0.f};
#pragma unroll
            for (int ks = 0; ks < 2; ++ks) a = mfma16(as_frag(*(const LAS v4u*)(Ks + (i0 + kt * 16 + fr) * WK_S + ks * 32 + 8 * fq)), qf[ks], a);
            st[kt] = a;
        }
        const int iq = i0 + fr + 128;
        float mx = sink;
#pragma unroll
        for (int kt = 0; kt < 18; ++kt)
#pragma unroll
            for (int r = 0; r < 4; ++r) { const int jj = i0 + kt * 16 + 4 * fq + r, t = t0 - 128 + jj; int dist = iq - jj; dist = dist < 0 ? -dist : dist;
                const bool ok = (dist <= 128) && (t >= 0) && (t < T);
                const float lg = ok ? st[kt][r] - slope * (float)dist : -INFINITY; st[kt][r] = lg; mx = fmaxf(mx, lg); }
        mx = fmaxf(mx, __shfl_xor(mx, 16)); mx = fmaxf(mx, __shfl_xor(mx, 32));
        float sum = 0.f;
#pragma unroll
        for (int kt = 0; kt < 18; ++kt)
#pragma unroll
            for (int r = 0; r < 4; ++r) { const float p = __expf(st[kt][r] - mx); st[kt][r] = p; sum += p; }
        sum += __shfl_xor(sum, 16); sum += __shfl_xor(sum, 32);
        const float inv = 1.f / (sum + __expf(sink - mx));
        f32x4 ot[4];
#pragma unroll
        for (int dt = 0; dt < 4; ++dt) ot[dt] = (f32x4){0.f, 0.f, 0.f, 0.f};
#pragma unroll
        for (int kk = 0; kk < 9; ++kk) {
            v4u pb; pb.x = pk2(st[2 * kk][0], st[2 * kk][1]); pb.y = pk2(st[2 * kk][2], st[2 * kk][3]); pb.z = pk2(st[2 * kk + 1][0], st[2 * kk + 1][1]); pb.w = pk2(st[2 * kk + 1][2], st[2 * kk + 1][3]);
#pragma unroll
            for (int dt = 0; dt < 4; ++dt) { const LAS bf16* vp = VT + prow(dt * 16 + fr) * WV_S + i0 + 32 * kk + 4 * fq;
                const v2u lo = *(const LAS v2u*)vp, hi = *(const LAS v2u*)(vp + 16); v4u va; va.x = lo.x; va.y = lo.y; va.z = hi.x; va.w = hi.y;
                ot[dt] = mfma16(as_frag(va), as_frag(pb), ot[dt]); }
        }
        const size_t row = (size_t)(m0 + i0 + fr);
#pragma unroll
        for (int dt = 0; dt < 4; ++dt) { const int d = H * 64 + dt * 16 + 4 * fq; const v2u z = *(const v2u*)(PROJ + row * PLD + C_ZATT + d);
            v2u o; o.x = pk2(ot[dt][0] * inv * silu(bf_lo(z.x)), ot[dt][1] * inv * silu(bf_hi(z.x))); o.y = pk2(ot[dt][2] * inv * silu(bf_lo(z.y)), ot[dt][3] * inv * silu(bf_hi(z.y)));
            if (EXPT == 2) { o.x = 0u; o.y = 0u; } *(v2u*)(CC + row * DM + 1024 + d) = o; }
    }
    __syncthreads();
}

constexpr int MK_S = 136, MV_S = 264;
__device__ __forceinline__ void mem_attn_item(LAS unsigned char* lds, const Params& P, int item) {
    const int tid = threadIdx.x, lane = tid & 63, w = tid >> 6, fr = lane & 15, fq = lane >> 4;
    const int cgi = item >> 2, hm = item & 3;
    int T, t0, bg; chunk_info(cgi, T, t0, bg);
    const int m0 = cgi * 128;
    const bf16* PROJ = (const bf16*)(P.ws + WS_PROJ); const bf16* MKV = (const bf16*)(P.ws + WS_MKV); bf16* CC = (bf16*)(P.ws + WS_CC);
    LAS bf16* MKs = (LAS bf16*)lds;
    LAS bf16* MVT = MKs + 256 * MK_S;
    {
        const int ch = tid & 15, j0 = (tid >> 4) * 8;
        const f32x4 g0 = *(const f32x4*)(P.mk_norm_g + ch * 8), g1 = *(const f32x4*)(P.mk_norm_g + ch * 8 + 4);
        v4u kin[8], vin[8], vout[8];
#pragma unroll
        for (int k = 0; k < 8; ++k) { const bf16* rowp = MKV + (size_t)(bg * 256 + j0 + k) * 1024 + hm * 128 + ch * 8; kin[k] = *(const v4u*)rowp; vin[k] = *(const v4u*)(rowp + 512); }
        __builtin_amdgcn_sched_barrier(0);
#pragma unroll
        for (int k = 0; k < 8; ++k) { const int mm = j0 + k; float kv[8];
            unpack8(kin[k], kv);
            float ss = 0.f;
#pragma unroll
            for (int e = 0; e < 8; ++e) ss += kv[e] * kv[e];
            ss += __shfl_xor(ss, 1); ss += __shfl_xor(ss, 2); ss += __shfl_xor(ss, 4); ss += __shfl_xor(ss, 8);
            const float rstd = rsqrtf(ss * (1.f / 128.f) + EPS);
            kv[0] *= rstd * g0.x; kv[1] *= rstd * g0.y; kv[2] *= rstd * g0.z; kv[3] *= rstd * g0.w; kv[4] *= rstd * g1.x; kv[5] *= rstd * g1.y; kv[6] *= rstd * g1.z; kv[7] *= rstd * g1.w;
            *(LAS v4u*)(MKs + mm * MK_S + ch * 8) = pack8(kv); }
        transpose8x8_bf16(vin, vout);
#pragma unroll
        for (int e = 0; e < 8; ++e) *(LAS v4u*)(MVT + prow(ch * 8 + e) * MV_S + j0) = vout[e];
    }
    __syncthreads();
    const int i0 = w * 16;
    bf16x8 qf[4];
    { float qv[4][8]; const bf16* qp = PROJ + (size_t)(m0 + i0 + fr) * PLD + C_MQ + hm * 128 + 8 * fq; float ss = 0.f;
#pragma unroll
      for (int ks = 0; ks < 4; ++ks) { unpack8(*(const v4u*)(qp + ks * 32), qv[ks]);
#pragma unroll
          for (int e = 0; e < 8; ++e) ss += qv[ks][e] * qv[ks][e]; }
      ss += __shfl_xor(ss, 16); ss += __shfl_xor(ss, 32);
      const float sc = rsqrtf(ss * (1.f / 128.f) + EPS) * 0.08838834764831845f;
#pragma unroll
      for (int ks = 0; ks < 4; ++ks) { const f32x4 ga = *(const f32x4*)(P.mq_norm_g + ks * 32 + 8 * fq), gb = *(const f32x4*)(P.mq_norm_g + ks * 32 + 8 * fq + 4);
          qv[ks][0] *= sc * ga.x; qv[ks][1] *= sc * ga.y; qv[ks][2] *= sc * ga.z; qv[ks][3] *= sc * ga.w; qv[ks][4] *= sc * gb.x; qv[ks][5] *= sc * gb.y; qv[ks][6] *= sc * gb.z; qv[ks][7] *= sc * gb.w;
          qf[ks] = as_frag(pack8(qv[ks])); } }
    f32x4 st[16];
#pragma unroll
    for (int kt = 0; kt < 16; ++kt) {
        f32x4 a = {0.f, 0.f, 0.f, 0.f};
#pragma unroll
        for (int ks = 0; ks < 4; ++ks) a = mfma16(as_frag(*(const LAS v4u*)(MKs + (kt * 16 + fr) * MK_S + ks * 32 + 8 * fq)), qf[ks], a);
        st[kt] = a;
    }
    float mx = -INFINITY;
#pragma unroll
    for (int kt = 0; kt < 16; ++kt)
#pragma unroll
        for (int r = 0; r < 4; ++r) mx = fmaxf(mx, st[kt][r]);
    mx = fmaxf(mx, __shfl_xor(mx, 16)); mx = fmaxf(mx, __shfl_xor(mx, 32));
    float sum = 0.f;
#pragma unroll
    for (int kt = 0; kt < 16; ++kt)
#pragma unroll
        for (int r = 0; r < 4; ++r) { const float p = __expf(st[kt][r] - mx); st[kt][r] = p; sum += p; }
    sum += __shfl_xor(sum, 16); sum += __shfl_xor(sum, 32);
    const float inv = 1.f / sum;
    f32x4 ot[8];
#pragma unroll
    for (int dt = 0; dt < 8; ++dt) ot[dt] = (f32x4){0.f, 0.f, 0.f, 0.f};
#pragma unroll
    for (int kk = 0; kk < 8; ++kk) {
        v4u pb; pb.x = pk2(st[2 * kk][0], st[2 * kk][1]); pb.y = pk2(st[2 * kk][2], st[2 * kk][3]); pb.z = pk2(st[2 * kk + 1][0], st[2 * kk + 1][1]); pb.w = pk2(st[2 * kk + 1][2], st[2 * kk + 1][3]);
#pragma unroll
        for (int dt = 0; dt < 8; ++dt) { const LAS bf16* vp = MVT + prow(dt * 16 + fr) * MV_S + 32 * kk + 4 * fq;
            const v2u lo = *(const LAS v2u*)vp, hi = *(const LAS v2u*)(vp + 16); v4u va; va.x = lo.x; va.y = lo.y; va.z = hi.x; va.w = hi.y;
            ot[dt] = mfma16(as_frag(va), as_frag(pb), ot[dt]); }
    }
    const size_t row = (size_t)(m0 + i0 + fr);
#pragma unroll
    for (int dt = 0; dt < 8; ++dt) { const int d = hm * 128 + dt * 16 + 4 * fq; const v2u z = *(const v2u*)(PROJ + row * PLD + C_ZMEM + d);
        v2u o; o.x = pk2(ot[dt][0] * inv * silu(bf_lo(z.x)), ot[dt][1] * inv * silu(bf_hi(z.x))); o.y = pk2(ot[dt][2] * inv * silu(bf_lo(z.y)), ot[dt][3] * inv * silu(bf_hi(z.y)));
        if (EXPT == 2) { o.x = 0u; o.y = 0u; } *(v2u*)(CC + row * DM + 1536 + d) = o; }
    __syncthreads();
}

__device__ __forceinline__ void scan_phase(const Params& P) {
    const bf16* ST = (const bf16*)(P.ws + WS_ST); bf16* SP = (bf16*)((unsigned char*)P.out + OUT_SP); const float* CD = (const float*)(P.ws + WS_CD);
    for (int idx = blockIdx.x * 512 + threadIdx.x; idx < 262144; idx += gridDim.x * 512) {
        const int n8 = idx & 15, p = (idx >> 4) & 63, h = (idx >> 10) & 15, dir = (idx >> 14) & 1, bgi = idx >> 15;
        const int cg0 = bgi < 4 ? bgi * 16 : 64 + (bgi - 4) * 64, nc = bgi < 4 ? 16 : 64;
        float S[8];
#pragma unroll
        for (int e = 0; e < 8; ++e) S[e] = 0.f;
        for (int s0 = 0; s0 < nc; s0 += 4) {
            v4u raw[4]; float cd[4]; size_t off[4];
#pragma unroll
            for (int u = 0; u < 4; ++u) { const int c = dir ? nc - 1 - (s0 + u) : s0 + u, cgi = cg0 + c;
                off[u] = (((size_t)(cgi * 2 + dir) * 16 + h) * 64 + p) * 128 + n8 * 8; raw[u] = *(const v4u*)(ST + off[u]); cd[u] = CD[(cgi * 4 + (h >> 2)) * 32 + dir * 4 + (h & 3)]; }
#pragma unroll
            for (int u = 0; u < 4; ++u) { float st[8]; unpack8(raw[u], st); *(v4u*)(SP + off[u]) = pack8(S);
#pragma unroll
                for (int e = 0; e < 8; ++e) S[e] = cd[u] * S[e] + st[e]; }
        }
    }
}

__device__ __forceinline__ void ssd_y_item(LAS unsigned char* lds, const Params& P, int item) {
    const int tid = threadIdx.x, lane = tid & 63, w = __builtin_amdgcn_readfirstlane(tid >> 6), fr = lane & 15, fq = lane >> 4;
    const int cgi = item >> 1, g = item & 1, head = g * 8 + w;
    const int m0 = cgi * 128;
    const bf16* PROJ = (const bf16*)(P.ws + WS_PROJ); const float* DT = (const float*)(P.ws + WS_DT);
    const bf16* BN = (const bf16*)(P.ws + WS_BN); const bf16* CN = (const bf16*)(P.ws + WS_CN); const bf16* XTg = (const bf16*)(P.ws + WS_XT); const bf16* ST = (const bf16*)((const unsigned char*)P.out + OUT_SP);
    bf16* CC = (bf16*)(P.ws + WS_CC);
    LAS bf16* Cs = (LAS bf16*)lds;
    LAS bf16* CBs = Cs + 128 * TS;
    LAS bf16* Bs = CBs + 128 * TS;
    LAS float* PF = (LAS float*)(Bs + 128 * TS);
    LAS float* RB = PF + 1024;
    LAS float* DF = RB + 1024;
    LAS float* DB = DF + 1024;
    LAS float* SQ = DB + 1024;
    LAS float* RS = SQ + 2048;
    LAS float* SCR = RS + 128;
    {
#pragma unroll
        for (int dir = 0; dir < 2; ++dir) {
            const float bias = P.dt_bias[dir * 16 + head], A = -__expf(P.a_log[dir * 16 + head]);
            const float r0 = DT[(size_t)(m0 + 2 * lane) * 32 + dir * 16 + head], r1 = DT[(size_t)(m0 + 2 * lane + 1) * 32 + dir * 16 + head];
            const float d0 = softplus(r0 + bias), d1 = softplus(r1 + bias), a0 = d0 * A, a1 = d1 * A;
            float tot; const float inc = wave_incl_scan(a0 + a1, lane, SCR + w * 64, tot);
            const float p1 = inc, p0 = inc - a1;
            if (dir == 0) { PF[w * 128 + 2 * lane] = p0; PF[w * 128 + 2 * lane + 1] = p1; DF[w * 128 + 2 * lane] = d0; DF[w * 128 + 2 * lane + 1] = d1; }
            else { RB[w * 128 + 2 * lane] = tot - p0 + a0; RB[w * 128 + 2 * lane + 1] = tot - p1 + a1; DB[w * 128 + 2 * lane] = d0; DB[w * 128 + 2 * lane + 1] = d1; }
        }
    }
    for (int q = tid; q < 4096; q += 512) { const int qq = q & 2047, c8 = qq & 15, j = qq >> 4;
        if (q < 2048) *(LAS v4u*)(Cs + j * TS + c8 * 8) = *(const v4u*)(CN + (size_t)(m0 + j) * 256 + g * 128 + c8 * 8);
        else *(LAS v4u*)(Bs + j * TS + c8 * 8) = *(const v4u*)(BN + (size_t)(m0 + j) * 256 + g * 128 + c8 * 8); }
    __syncthreads();
    {
        f32x4 cb[8];
#pragma unroll
        for (int jt = 0; jt < 8; ++jt) cb[jt] = (f32x4){0.f, 0.f, 0.f, 0.f};
#pragma unroll
        for (int ks = 0; ks < 4; ++ks) { const bf16x8 a = as_frag(*(const LAS v4u*)(Cs + (w * 16 + fr) * TS + ks * 32 + 8 * fq));
#pragma unroll
            for (int jt = 0; jt < 8; ++jt) cb[jt] = mfma16(a, as_frag(*(const LAS v4u*)(Bs + (jt * 16 + fr) * TS + ks * 32 + 8 * fq)), cb[jt]); }
#pragma unroll
        for (int jt = 0; jt < 8; ++jt)
#pragma unroll
            for (int r = 0; r < 4; ++r) CBs[(w * 16 + 4 * fq + r) * TS + jt * 16 + fr] = f2bf(cb[jt][r]);
    }
    __syncthreads();
    const float Dh = P.d_skip[head];
    const char* SpF = (const char*)(ST + ((size_t)(cgi * 2 + 0) * 16 + head) * 8192); const char* SpB = SpF + (size_t)16 * 8192 * 2;
    const char* Xp = (const char*)(XTg + ((size_t)cgi * 1024 + head * 64) * 128);
#define LD8(dst, arr) do { const f32x4 _a = *(const LAS f32x4*)((arr) + w * 128 + jb), _b = *(const LAS f32x4*)((arr) + w * 128 + jb + 4); \
        dst[0] = _a.x; dst[1] = _a.y; dst[2] = _a.z; dst[3] = _a.w; dst[4] = _b.x; dst[5] = _b.y; dst[6] = _b.z; dst[7] = _b.w; } while (0)
#pragma unroll 1
    for (int ph = 0; ph < 2; ++ph) {
        f32x4 acc[8][2];
#pragma unroll
        for (int it = 0; it < 8; ++it) { acc[it][0] = (f32x4){0.f, 0.f, 0.f, 0.f}; acc[it][1] = (f32x4){0.f, 0.f, 0.f, 0.f}; }
        const unsigned vo0 = (unsigned)((((2 * ph) * 16 + fr) * 128 + 8 * fq) * 2), vo1 = vo0 + 16 * 128 * 2;
#pragma unroll 1
        for (int s = 0; s < 8; ++s) {
            const int ks = s & 3, jb = ks * 32 + 8 * fq; const char* base = (s < 4 ? SpF : SpB) + ks * 64;
            unsigned va = vo0, vb = vo1; asm volatile("" : "+v"(va), "+v"(vb));
            const bf16x8 f0 = as_frag(*(const v4u*)(base + va)), f1 = as_frag(*(const v4u*)(base + vb));
            const LAS float* cum = (s < 4 ? PF : RB) + w * 128;
#pragma unroll
            for (int it = 0; it < 8; ++it) { const int i = it * 16 + fr; const float sc = __expf(cum[i]); float cv[8]; unpack8(*(const LAS v4u*)(Cs + i * TS + jb), cv);
#pragma unroll
                for (int e = 0; e < 8; ++e) cv[e] *= sc;
                const bf16x8 a = as_frag(pack8(cv));
                acc[it][0] = mfma16(f0, a, acc[it][0]); acc[it][1] = mfma16(f1, a, acc[it][1]); }
        }
#pragma unroll 1
        for (int ks = 0; ks < 4; ++ks) {
            const int jb = ks * 32 + 8 * fq; const char* base = Xp + ks * 64;
            unsigned va = vo0, vb = vo1; asm volatile("" : "+v"(va), "+v"(vb));
            const bf16x8 f0 = as_frag(*(const v4u*)(base + va)), f1 = as_frag(*(const v4u*)(base + vb));
            const float pref = PF[w * 128 + ks * 32 + 31], rref = RB[w * 128 + ks * 32];
#pragma unroll
            for (int it = 0; it < 8; ++it) { const int i = it * 16 + fr; const float pi = PF[w * 128 + i], ri = RB[w * 128 + i];
                const int rel = it * 16 - ks * 32;
                float cv[8]; unpack8(*(const LAS v4u*)(CBs + i * TS + jb), cv);
                if (rel >= 32) { const float ei = __expf(fminf(pi - pref, 0.f)); float pj[8], dfj[8]; LD8(pj, PF); LD8(dfj, DF);
#pragma unroll
                    for (int e = 0; e < 8; ++e) cv[e] *= ei * (__expf(fminf(pref - pj[e], 0.f)) * dfj[e]); }
                else if (rel <= -16) { const float ei = __expf(fminf(ri - rref, 0.f)); float rj[8], dbj[8]; LD8(rj, RB); LD8(dbj, DB);
#pragma unroll
                    for (int e = 0; e < 8; ++e) cv[e] *= ei * (__expf(fminf(rref - rj[e], 0.f)) * dbj[e]); }
                else { float tf[8]; const float dsum = DF[w * 128 + i] + DB[w * 128 + i];
                    { float pj[8], dfj[8]; LD8(pj, PF); LD8(dfj, DF);
#pragma unroll
                      for (int e = 0; e < 8; ++e) tf[e] = __expf(fminf(pi - pj[e], 0.f)) * dfj[e]; }
                    __builtin_amdgcn_sched_barrier(0);
                    { float rj[8], dbj[8]; LD8(rj, RB); LD8(dbj, DB);
#pragma unroll
                      for (int e = 0; e < 8; ++e) { const int j = jb + e; const float eb = __expf(fminf(ri - rj[e], 0.f)) * dbj[e];
                          const float m = j < i ? tf[e] : (j > i ? eb : dsum); cv[e] = cv[e] * m + (j == i ? Dh : 0.f); } } }
                const bf16x8 a = as_frag(pack8(cv));
                acc[it][0] = mfma16(f0, a, acc[it][0]); acc[it][1] = mfma16(f1, a, acc[it][1]);
                __builtin_amdgcn_sched_barrier(0); }
        }
        char* cb2 = (char*)(CC + (size_t)m0 * DM + head * 64 + ph * 32);
#pragma unroll
        for (int it = 0; it < 8; ++it) { unsigned vc = (unsigned)(((it * 16 + fr) * DM + 4 * fq) * 2); asm volatile("" : "+v"(vc));
#pragma unroll
            for (int ptl = 0; ptl < 2; ++ptl) { v2u o; o.x = pk2(acc[it][ptl][0], acc[it][ptl][1]); o.y = pk2(acc[it][ptl][2], acc[it][ptl][3]); *(v2u*)(cb2 + vc + ptl * 32) = o; } }
    }
#undef LD8
    asm volatile("s_waitcnt vmcnt(0)" ::: "memory");
    __syncthreads();
    {
        const f32x4 g0 = *(const f32x4*)(P.ssd_norm_g + g * 512 + lane * 8), g1 = *(const f32x4*)(P.ssd_norm_g + g * 512 + lane * 8 + 4);
        bf16* crow = CC + (size_t)(m0 + w * 16) * DM + g * 512 + lane * 8; const bf16* zrow = PROJ + (size_t)(m0 + w * 16) * PLD + C_ZSSD + g * 512 + lane * 8;
#pragma unroll 1
        for (int kb = 0; kb < 2; ++kb) {
            v4u yv[8], zv[8];
#pragma unroll
            for (int k = 0; k < 8; ++k) { yv[k] = __builtin_nontemporal_load((const v4u*)(crow + (size_t)(kb * 8 + k) * DM)); zv[k] = *(const v4u*)(zrow + (size_t)(kb * 8 + k) * PLD); }
#pragma unroll
            for (int k = 0; k < 8; ++k) { float y[8], z[8]; unpack8(yv[k], y); unpack8(zv[k], z); float s = 0.f;
#pragma unroll
                for (int e = 0; e < 8; ++e) { y[e] *= silu(z[e]); s += y[e] * y[e]; }
                const float rs = rsqrtf(wave_sum(s) * (1.f / 512.f) + EPS);
                y[0] *= rs * g0.x; y[1] *= rs * g0.y; y[2] *= rs * g0.z; y[3] *= rs * g0.w; y[4] *= rs * g1.x; y[5] *= rs * g1.y; y[6] *= rs * g1.z; y[7] *= rs * g1.w;
                v4u o = pack8(y); if (EXPT == 1) o = (v4u){0u, 0u, 0u, 0u};
                *(v4u*)(crow + (size_t)(kb * 8 + k) * DM) = o; }
        }
    }
    __syncthreads();
}

#define RLX_AGENT __ATOMIC_RELAXED, __HIP_MEMORY_SCOPE_AGENT
#define XB_TMO      128
#define XB_XCNT(j)  (256  + 64 * (j))
#define XB_XSUB(j)  (1280 + 64 * (j))
#define XB_XGEN(j)  (2304 + 64 * (j))
#define XB_TOP      3328
#define XB_TOPGEN   3392
#define XCD_BAR_WORDS 3456
#define XB_SPIN_CAP (1u << 18)

__device__ __forceinline__ unsigned xb_ld(unsigned* p)              { return __hip_atomic_load(p, __ATOMIC_RELAXED, __HIP_MEMORY_SCOPE_AGENT); }
__device__ __forceinline__ unsigned xb_add(unsigned* p, unsigned v) { return __hip_atomic_fetch_add(p, v, __ATOMIC_RELAXED, __HIP_MEMORY_SCOPE_AGENT); }
__device__ __forceinline__ unsigned xb_xcc_id() { return (unsigned)__builtin_amdgcn_s_getreg((3 << 11) | 20) & 0xFu; }
#define XB_SPIN(cond, bar) do { unsigned _sp = 0; while (cond) { __builtin_amdgcn_s_sleep(1); \
    if ((++_sp & 255u) == 0u) { if (xb_ld(&(bar)[XB_TMO])) break; if (_sp > XB_SPIN_CAP) { atomicAdd(&(bar)[XB_TMO], 1u); break; } } } } while (0)

struct XcdBarrier {
    unsigned* bar; unsigned x;
    volatile LAS unsigned* st;
};

__device__ __forceinline__ XcdBarrier xcd_barrier_post(unsigned* bar, volatile LAS unsigned* st) {
    XcdBarrier b; b.bar = bar; b.x = xb_xcc_id(); b.st = st;
    if (threadIdx.x == 0) (void)xb_add(&bar[XB_XCNT(b.x)], 1u);
    return b;
}
__device__ __forceinline__ void xcd_barrier_complete(unsigned* bar, unsigned x, unsigned& nloc, unsigned& nx) {
    const unsigned G = gridDim.x * gridDim.y * gridDim.z;
    unsigned sum, cnt, mine, sp = 0u;
    for (;;) {
        sum = 0u; cnt = 0u; mine = 0u;
#pragma unroll
        for (unsigned j = 0; j < 16; ++j) { const unsigned c = xb_ld(&bar[XB_XCNT(j)]); sum += c; cnt += (c > 0u) ? 1u : 0u; mine = (j == x) ? c : mine; }
        if (sum == G) break;
        __builtin_amdgcn_s_sleep(1);
        if ((++sp & 255u) == 0u) { if (xb_ld(&bar[XB_TMO])) break; if (sp > XB_SPIN_CAP) { atomicAdd(&bar[XB_TMO], 1u); break; } }
    }
    nloc = mine > 0u ? mine : 1u; nx = cnt > 0u ? cnt : 1u;
}

__device__ __forceinline__ void xcd_barrier(const XcdBarrier& b) {
    asm volatile("s_waitcnt vmcnt(0)" ::: "memory");
    __syncthreads();
    if (threadIdx.x == 0) {
        unsigned* bar = b.bar;
        __builtin_amdgcn_s_waitcnt(0);
        unsigned nloc = b.st[0], nx = b.st[1];
        if (nloc == 0u) { xcd_barrier_complete(bar, b.x, nloc, nx); b.st[0] = nloc; b.st[1] = nx; }
        const unsigned old = xb_add(&bar[XB_XSUB(b.x)], 1u);
        const unsigned gen = old / nloc;
        if (old + 1u == (gen + 1u) * nloc) {
            __builtin_amdgcn_fence(__ATOMIC_RELEASE, "agent");
            asm volatile("s_waitcnt vmcnt(0)" ::: "memory");
            const unsigned og = xb_add(&bar[XB_TOP], 1u);
            const unsigned tg = og / nx;
            if (og + 1u == (tg + 1u) * nx) xb_add(&bar[XB_TOPGEN], 1u);
            else XB_SPIN(xb_ld(&bar[XB_TOPGEN]) == tg, bar);
            __builtin_amdgcn_fence(__ATOMIC_ACQUIRE, "agent");
            xb_add(&bar[XB_XGEN(b.x)], 1u);
            asm volatile("s_waitcnt vmcnt(0)" ::: "memory");
        } else {
            XB_SPIN(xb_ld(&bar[XB_XGEN(b.x)]) == gen, bar);
            __builtin_amdgcn_fence(__ATOMIC_ACQUIRE, "agent");
            asm volatile("s_waitcnt vmcnt(0)" ::: "memory");
        }
    }
    __syncthreads();
}

__global__ void __launch_bounds__(512, 2) hymba_fwd(Params P) {
    extern __shared__ __attribute__((aligned(16))) unsigned char lds_raw[];
    LAS unsigned char* lds = (LAS unsigned char*)lds_raw;
    if (P.ws == nullptr) cg::this_grid().sync();
    if (threadIdx.x < 8) ((LAS unsigned*)(lds + LDS_BYTES - 32))[threadIdx.x] = 0u;
    __syncthreads();
    XcdBarrier bar = xcd_barrier_post((unsigned*)(P.ws + WS_BAR), (volatile LAS unsigned*)(lds + LDS_BYTES - 32));
#define GRID_SYNC() xcd_barrier(bar)
    const int G = gridDim.x, c = blockIdx.x;

    p0_prologue(lds, P);
    GRID_SYNC();

    {
        pg8::Gemm g1{(const bf16*)((const unsigned char*)P.out + OUT_XN), (const bf16*)(P.ws + WS_WIN), MTOT, DINP, DM}; pg8::StaticOrder S1; S1.init(MTOT, DINP, G, c);
        EpiProj E1{(bf16*)(P.ws + WS_PROJ), (float*)(P.ws + WS_DT)};
        pg8::gemm_phase<EpiProj, pg8::StaticOrder, true, true>(lds, g1, S1, E1);
        pg8::Gemm g2{(const bf16*)(P.ws + WS_MEMN), (const bf16*)(P.ws + WS_WMEM), 2048, 1024, DM}; MemOrder S2{c, G};
        EpiPlain E2{(bf16*)(P.ws + WS_MKV), 1024};
        pg8::gemm_phase<EpiPlain, MemOrder, true, true>(lds, g2, S2, E2);
    }
    GRID_SYNC();

    unsigned* ctr = (unsigned*)P.ws;
    LAS volatile int* slot = (LAS volatile int*)(lds + LDS_BYTES - 16);
#define RUN_QUEUE(CTR, NITEMS, BODY) do { \
        int it_; if (threadIdx.x == 0) slot[0] = (int)__hip_atomic_fetch_add((CTR), 1u, __ATOMIC_RELAXED, __HIP_MEMORY_SCOPE_AGENT); \
        __syncthreads(); it_ = slot[0]; __syncthreads(); \
        while (it_ < (NITEMS)) { \
            int nxt_ = 0; if (threadIdx.x == 0) nxt_ = (int)__hip_atomic_fetch_add((CTR), 1u, __ATOMIC_RELAXED, __HIP_MEMORY_SCOPE_AGENT); \
            { const int it = it_; BODY } \
            if (threadIdx.x == 0) slot[0] = nxt_; \
            __syncthreads(); it_ = slot[0]; __syncthreads(); \
        } } while (0)
    RUN_QUEUE(ctr, 1920, if (it < 640) win_attn_item(lds, P, it); else ssd_state_item(lds, P, it - 640););
    GRID_SYNC();

    scan_phase(P);
    GRID_SYNC();

    RUN_QUEUE(ctr + 64, 640, ssd_y_item(lds, P, it););
    RUN_QUEUE(ctr + 128, 1280, mem_attn_item(lds, P, it););
    GRID_SYNC();
#undef RUN_QUEUE

    {
        pg8::Gemm g5{(const bf16*)(P.ws + WS_CC), (const bf16*)(P.ws + WS_WOUT), MTOT, DM, DM}; pg8::StaticOrder S5; S5.init(MTOT, DM, G, c);
        EpiOut E5{P.x_prompt, P.x_sample, P.out};
        pg8::gemm_phase<EpiOut, pg8::StaticOrder, true, true>(lds, g5, S5, E5);
    }
}

extern "C" void kernel_launch(void* const* d_in, const int* in_sizes, int n_in, void* d_out, int out_size, void* d_ws, size_t ws_size, hipStream_t stream) {
    static int grid = 0;
    if (grid == 0) {
        if (n_in != 20 || out_size != MTOT * DM || ws_size < WS_END) { fprintf(stderr, "kernel_launch: unexpected problem (n_in %d, out %d, ws %zu)\n", n_in, out_size, ws_size); grid = -1; return; }
        int dev = 0, cus = 0, per_cu = 0;
        hipGetDevice(&dev); hipDeviceGetAttribute(&cus, hipDeviceAttributeMultiprocessorCount, dev);
        if (hipFuncSetAttribute((const void*)hymba_fwd, hipFuncAttributeMaxDynamicSharedMemorySize, LDS_BYTES) != hipSuccess) { fprintf(stderr, "kernel_launch: hipFuncSetAttribute failed\n"); grid = -1; return; }
        if (hipOccupancyMaxActiveBlocksPerMultiprocessor(&per_cu, (const void*)hymba_fwd, 512, LDS_BYTES) != hipSuccess || per_cu < 1) { fprintf(stderr, "kernel_launch: occupancy query says %d\n", per_cu); per_cu = 1; }
        (void)hipGetLastError();
        grid = cus;
    }
    if (grid < 0) return;
    if (hipMemsetAsync(d_ws, 0, WS_CTL_BYTES, stream) != hipSuccess) { fprintf(stderr, "kernel_launch: hipMemsetAsync failed\n"); return; }
    Params p{};
    const float** f = (const float**)&p;
    for (int i = 0; i < 20; ++i) f[i] = (const float*)d_in[i];
    p.out = (float*)d_out; p.ws = (unsigned char*)d_ws;
    void* args[] = {&p};
    hipError_t e = hipLaunchCooperativeKernel((const void*)hymba_fwd, dim3(grid), dim3(512), args, LDS_BYTES, stream);
    if (e != hipSuccess) fprintf(stderr, "cooperative launch failed: %s (grid %d)\n", hipGetErrorString(e), grid);
}
```

```cpp
#include <hip/hip_runtime.h>
#include <hip/hip_cooperative_groups.h>
#include <cstdio>
#include <cstdint>
namespace cg = cooperative_groups;
namespace pg8 {
#define PG8_LAS __attribute__((address_space(3)))
typedef unsigned short bf16_t;
typedef short bf16x8 __attribute__((ext_vector_type(8)));
typedef float f32x4 __attribute__((ext_vector_type(4)));
typedef unsigned u32x4 __attribute__((ext_vector_type(4)));
constexpr int BM = 256, BK = 64, HALF = 128, HTB = HALF * BK * 2  , STAGE_BYTES = 8 * HTB, NXCD = 8, WGM = 8;

__host__ __device__ __forceinline__ int lds_byte(int r, int c) { const int st = (r >> 4) * 2 + (c >> 5), rr = r & 15, cc = c & 31, ob = rr * 64 + cc * 2; return st * 1024 + (ob ^ (((ob >> 9) & 1) << 5)); }
__host__ __device__ __forceinline__ void stage_rc(int b, int& R, int& C) { const int st = b / 1024, sb = b % 1024, swz = sb ^ (((sb >> 9) & 1) << 5); R = (st >> 1) * 16 + swz / 64; C = (st & 1) * 32 + (swz % 64) / 2; }
__host__ __device__ __forceinline__ int perm32(int rho) { const int n = rho >> 4, i = rho & 15; return 8 * (i >> 2) + 4 * n + (i & 3); }

struct Unit { int pm, pn; };
struct Gemm { const bf16_t* A; const bf16_t* Bt; int M, N, K; };

struct StaticOrder {
    int nM, nN, nwg, G, c;
    __host__ __device__ void init(int M, int N, int G_, int c_) { nM = M / BM; nN = N / BM; nwg = nM * nN; G = G_; c = c_; }
    __host__ __device__ bool next(int i, Unit& u) const {
        const long L = (long)i * G + c; if (L >= nwg) return false;
        int wgid = (int)L; { const int q = nwg / NXCD, r = nwg % NXCD, xcd = wgid % NXCD, off = wgid / NXCD; wgid = (xcd < r ? xcd * (q + 1) : r * (q + 1) + (xcd - r) * q) + off; }
        const int nig = WGM * nN, gid = wgid / nig, fm = gid * WGM, gsz = (nM - fm) < WGM ? (nM - fm) : WGM;
        u.pm = fm + ((wgid % nig) % gsz); u.pn = (wgid % nig) / gsz; return true;
    }
    __device__ __forceinline__ void a_ready(const Unit&) const {}
    __device__ __forceinline__ void done(const Unit&) const {}
};

__device__ __forceinline__ unsigned cvt_pk_bf16(float lo, float hi) { unsigned r; asm volatile("v_cvt_pk_bf16_f32 %0, %1, %2" : "=v"(r) : "v"(lo), "v"(hi)); return r; }
template <class Epi, class Sched, bool ALIGN_EPI = false, bool SP2 = false>
__device__ __forceinline__ void gemm_phase(PG8_LAS unsigned char* lds, const Gemm g, const Sched& S, const Epi& E) {
    const int tid = threadIdx.x, wid = __builtin_amdgcn_readfirstlane(tid >> 6), lane = tid & 63, wr = wid >> 2, wc = wid & 3, fr = lane & 15, fq = lane >> 4;
    const int K = g.K, nt = K / BK;
    unsigned voffA[2], voffB[2];
#pragma unroll
    for (int i = 0; i < 2; ++i) { int R, C; stage_rc(tid * 16 + i * 8192, R, C); const int Rb = Epi::PERM ? ((R & ~31) + perm32(R & 31)) : R;
        voffA[i] = (unsigned)(R * K + C) * 2u; voffB[i] = (unsigned)(Rb * K + C) * 2u; }
    const size_t kstep = (size_t)(BK * 2);
    const size_t hstep = (size_t)HALF * K * 2;
    const size_t tstep = 2 * hstep;
    const unsigned ldsw = (unsigned)wid * 1024u;
    const int aoff = lds_byte(wr * 64 + fr, fq * 8), boff = lds_byte(wc * 32 + fr, fq * 8);
#define PG8_SA(b, h) (((b) * 2 + (h)) * HTB)
#define PG8_SB(b, h) ((4 + (b) * 2 + (h)) * HTB)
#define PG8_STAGE(bufoff, gbase, voff) do { _Pragma("unroll") for (int _i = 0; _i < 2; ++_i) \
        __builtin_amdgcn_global_load_lds((const unsigned*)((const char*)(gbase) + (voff)[_i]), (PG8_LAS unsigned*)(lds + (bufoff) + ldsw + _i * 8192), 16, 0, 0); } while (0)
#define PG8_LDA(dst, b, h) do { _Pragma("unroll") for (int m = 0; m < 4; ++m) _Pragma("unroll") for (int k = 0; k < 2; ++k) dst[m][k] = *(const PG8_LAS bf16x8*)(lds + PG8_SA(b, h) + aoff + m * 2048 + k * 1024); } while (0)
#define PG8_LDB(dst, b, h) do { _Pragma("unroll") for (int n = 0; n < 2; ++n) _Pragma("unroll") for (int k = 0; k < 2; ++k) dst[n][k] = *(const PG8_LAS bf16x8*)(lds + PG8_SB(b, h) + boff + n * 2048 + k * 1024); } while (0)
#define PG8_MMA(ai, bj, At, Bt) do { __builtin_amdgcn_s_setprio(1); _Pragma("unroll") for (int m = 0; m < 4; ++m) _Pragma("unroll") for (int n = 0; n < 2; ++n) _Pragma("unroll") for (int k = 0; k < 2; ++k) \
        acc[ai][bj][m][n] = __builtin_amdgcn_mfma_f32_16x16x32_bf16(Bt[n][k], At[m][k], acc[ai][bj][m][n], 0, 0, 0); __builtin_amdgcn_s_setprio(0); } while (0)
#define PG8_WAIT_V(n) asm volatile("s_waitcnt vmcnt(" #n ")" ::: "memory")
#define PG8_WAIT_L(n) asm volatile("s_waitcnt lgkmcnt(" #n ")" ::: "memory")
#define PG8_BAR __builtin_amdgcn_s_barrier()
#define PG8_SCHED __builtin_amdgcn_sched_barrier(0)
    Unit cur, nxt; int ui = 0;
    if (!S.next(0, cur)) return;
    f32x4 acc[2][2][4][2];
#pragma unroll
    for (int a = 0; a < 2; ++a)
#pragma unroll
        for (int b = 0; b < 2; ++b)
#pragma unroll
            for (int m = 0; m < 4; ++m)
#pragma unroll
                for (int n = 0; n < 2; ++n) acc[a][b][m][n] = (f32x4){0.f, 0.f, 0.f, 0.f};
    bf16x8 At[4][2], B0[2][2], B1[2][2];
    const char* cA = (const char*)g.A + (size_t)cur.pm * tstep; const char* cB = (const char*)g.Bt + (size_t)cur.pn * tstep;
    S.a_ready(cur);
    if constexpr (SP2) {
        PG8_STAGE(PG8_SB(0, 0), cB, voffB); PG8_STAGE(PG8_SB(0, 1), cB + hstep, voffB); PG8_STAGE(PG8_SA(0, 0), cA, voffA); PG8_STAGE(PG8_SA(0, 1), cA + hstep, voffA);
        if (wr == 1) PG8_BAR;
        PG8_WAIT_V(2); PG8_BAR;
        PG8_STAGE(PG8_SB(1, 0), cB + kstep, voffB); PG8_STAGE(PG8_SA(1, 0), cA + kstep, voffA); PG8_STAGE(PG8_SB(1, 1), cB + hstep + kstep, voffB);
        PG8_WAIT_V(6); PG8_BAR;
    } else {
        PG8_STAGE(PG8_SB(0, 0), cB, voffB); PG8_STAGE(PG8_SA(0, 0), cA, voffA); PG8_STAGE(PG8_SB(0, 1), cB + hstep, voffB); PG8_STAGE(PG8_SA(0, 1), cA + hstep, voffA);
        if (wr == 1) PG8_BAR;
        PG8_WAIT_V(4); PG8_BAR;
        PG8_STAGE(PG8_SB(1, 0), cB + kstep, voffB); PG8_STAGE(PG8_SA(1, 0), cA + kstep, voffA); PG8_STAGE(PG8_SB(1, 1), cB + hstep + kstep, voffB);
        PG8_WAIT_V(6); PG8_BAR;
    }
    for (;;) {
        const bool has_next = S.next(ui + 1, nxt);
        const char* nA = has_next ? (const char*)g.A + (size_t)nxt.pm * tstep : cA; const char* nB = has_next ? (const char*)g.Bt + (size_t)nxt.pn * tstep : cB;
        for (int t = 0; t < nt; t += 2) {
            const bool last = (t == nt - 2);
            const char* a1 = cA + (size_t)(t + 1) * kstep;
            const char* a2 = last ? nA : cA + (size_t)(t + 2) * kstep; const char* b2 = last ? nB : cB + (size_t)(t + 2) * kstep;
            const char* a3 = a2 + kstep; const char* b3 = b2 + kstep;
            if (last && has_next) S.a_ready(nxt);
            if constexpr (SP2) {
            PG8_LDB(B0, 0, 0); PG8_LDB(B1, 0, 1); PG8_SCHED; PG8_LDA(At, 0, 0); PG8_STAGE(PG8_SA(1, 1), a1 + hstep, voffA);
            PG8_WAIT_V(8); PG8_WAIT_L(0); PG8_BAR; PG8_MMA(0, 0, At, B0); PG8_MMA(0, 1, At, B1); PG8_BAR; PG8_SCHED;
            PG8_LDA(At, 0, 1); PG8_STAGE(PG8_SB(0, 0), b2, voffB); PG8_STAGE(PG8_SB(0, 1), b2 + hstep, voffB); PG8_STAGE(PG8_SA(0, 0), a2, voffA);
            PG8_WAIT_V(8); PG8_WAIT_L(0); PG8_BAR; PG8_MMA(1, 0, At, B0); PG8_MMA(1, 1, At, B1); PG8_BAR; PG8_SCHED;
            PG8_LDB(B0, 1, 0); PG8_LDB(B1, 1, 1); PG8_SCHED; PG8_LDA(At, 1, 0); PG8_STAGE(PG8_SA(0, 1), a2 + hstep, voffA);
            PG8_WAIT_V(8); PG8_WAIT_L(0); PG8_BAR; PG8_MMA(0, 0, At, B0); PG8_MMA(0, 1, At, B1); PG8_BAR; PG8_SCHED;
            PG8_LDA(At, 1, 1); PG8_STAGE(PG8_SB(1, 0), b3, voffB); PG8_STAGE(PG8_SB(1, 1), b3 + hstep, voffB); PG8_STAGE(PG8_SA(1, 0), a3, voffA);
            PG8_WAIT_V(8); PG8_WAIT_L(0); PG8_BAR; PG8_MMA(1, 0, At, B0); PG8_MMA(1, 1, At, B1); PG8_BAR; PG8_SCHED;
            } else {
            PG8_LDB(B0, 0, 0); PG8_SCHED; PG8_LDA(At, 0, 0); PG8_STAGE(PG8_SA(1, 1), a1 + hstep, voffA);
            PG8_WAIT_L(8); PG8_BAR; PG8_WAIT_L(0); PG8_MMA(0, 0, At, B0); PG8_BAR; PG8_SCHED;
            PG8_LDB(B1, 0, 1); PG8_STAGE(PG8_SB(0, 0), b2, voffB);
            PG8_BAR; PG8_WAIT_L(0); PG8_MMA(0, 1, At, B1); PG8_BAR;
            PG8_LDA(At, 0, 1); PG8_STAGE(PG8_SA(0, 0), a2, voffA);
            PG8_BAR; PG8_WAIT_L(0); PG8_MMA(1, 0, At, B0); PG8_BAR; PG8_SCHED;
            PG8_STAGE(PG8_SB(0, 1), b2 + hstep, voffB);
            PG8_WAIT_V(6); PG8_BAR; PG8_MMA(1, 1, At, B1); PG8_BAR;
            PG8_LDB(B0, 1, 0); PG8_SCHED; PG8_LDA(At, 1, 0); PG8_STAGE(PG8_SA(0, 1), a2 + hstep, voffA);
            PG8_WAIT_L(8); PG8_BAR; PG8_WAIT_L(0); PG8_MMA(0, 0, At, B0); PG8_BAR; PG8_SCHED;
            PG8_LDB(B1, 1, 1); PG8_STAGE(PG8_SB(1, 0), b3, voffB);
            PG8_BAR; PG8_WAIT_L(0); PG8_MMA(0, 1, At, B1); PG8_BAR;
            PG8_LDA(At, 1, 1); PG8_STAGE(PG8_SA(1, 0), a3, voffA);
            PG8_BAR; PG8_WAIT_L(0); PG8_MMA(1, 0, At, B0); PG8_BAR; PG8_SCHED;
            PG8_STAGE(PG8_SB(1, 1), b3 + hstep, voffB);
            PG8_WAIT_V(6); PG8_BAR; PG8_MMA(1, 1, At, B1); PG8_BAR;
            }
        }
        if constexpr (ALIGN_EPI) { if (wr == 0) PG8_BAR; }
        if constexpr (!Epi::AFTER_DRAIN) { E(acc, cur, wr, wc, fr, fq); S.done(cur); }
        if (!has_next) break;
#pragma unroll
        for (int a = 0; a < 2; ++a)
#pragma unroll
            for (int b = 0; b < 2; ++b)
#pragma unroll
                for (int m = 0; m < 4; ++m)
#pragma unroll
                    for (int n = 0; n < 2; ++n) acc[a][b][m][n] = (f32x4){0.f, 0.f, 0.f, 0.f};
        cur = nxt; cA = nA; cB = nB; ++ui;
        if constexpr (ALIGN_EPI) { if (wr == 1) PG8_BAR; }
    }
    PG8_WAIT_V(0);
    if constexpr (!ALIGN_EPI) { if (wr == 0) PG8_BAR; }
    PG8_BAR;
    if constexpr (Epi::AFTER_DRAIN) { E.fused(acc, cur, wr, wc, fr, fq, lds, wid, lane); S.done(cur); }
#undef PG8_SA
#undef PG8_SB
#undef PG8_STAGE
#undef PG8_LDA
#undef PG8_LDB
#undef PG8_MMA
#undef PG8_WAIT_V
#undef PG8_WAIT_L
#undef PG8_BAR
#undef PG8_SCHED
}
}

#define LAS __attribute__((address_space(3)))
typedef unsigned short bf16;
typedef unsigned v4u __attribute__((ext_vector_type(4)));
typedef unsigned v2u __attribute__((ext_vector_type(2)));
typedef float f32x4 __attribute__((ext_vector_type(4)));
typedef short bf16x8 __attribute__((ext_vector_type(8)));
constexpr int DM = 2048, MTOT = 40960, MPROMPT = 8192, DIN = 4896, DINP = 5120, PLD = 4928  , NCHUNKS = 320;
constexpr int C_ZSSD = 1536, C_DT = 2560, C_Q = 2592, C_K = 3104, C_V = 3232, C_ZATT = 3360, C_MQ = 3872, C_ZMEM = 4384;
constexpr float EPS = 1e-6f;
constexpr size_t MiB = 1u << 20;
constexpr size_t WS_WIN = 2 * MiB, WS_WOUT = 22 * MiB, WS_WMEM = 30 * MiB, WS_MEMN = 34 * MiB, WS_MKV = 42 * MiB, WS_DT = 46 * MiB, WS_CD = 51 * MiB,
                 WS_BN = 52 * MiB, WS_CN = 72 * MiB, WS_XT = 92 * MiB, WS_ST = 172 * MiB, WS_CC = 332 * MiB, WS_PROJ = 492 * MiB, WS_END = 878 * MiB;
constexpr size_t OUT_XN = 0, OUT_SP = 160 * MiB;
constexpr size_t WS_BAR = 65536, WS_CTL_BYTES = 131072;
constexpr int LDS_BYTES = 147456;
#ifndef EXPT
#define EXPT 0
#endif
#ifndef DUPMASK
#define DUPMASK 0
#endif
#ifndef GEMM_ALIGN
#define GEMM_ALIGN true
#endif

struct Params {
    const float *x_prompt, *x_sample, *mem_prompt, *mem_sample, *norm_g, *w_in, *conv_w, *conv_b, *dt_bias, *a_log, *d_skip, *ssd_norm_g, *q_norm_g, *k_norm_g, *sink,
                *mem_norm_g, *w_mem_kv, *mq_norm_g, *mk_norm_g, *w_out;
    float* out; unsigned char* ws;
};

__device__ __forceinline__ float bf_lo(unsigned u) { return __uint_as_float(u << 16); }
__device__ __forceinline__ float bf_hi(unsigned u) { return __uint_as_float(u & 0xffff0000u); }
__device__ __forceinline__ float bf1(bf16 v) { return __uint_as_float((unsigned)v << 16); }
typedef float f32x2_t __attribute__((ext_vector_type(2))); typedef __bf16 bf16x2_t __attribute__((ext_vector_type(2)));
__device__ __forceinline__ unsigned pk2(float lo, float hi) { f32x2_t v = {lo, hi}; bf16x2_t b = __builtin_convertvector(v, bf16x2_t); return __builtin_bit_cast(unsigned, b); }
__device__ __forceinline__ bf16 f2bf(float f) { return (bf16)(pk2(f, 0.f) & 0xffffu); }
__device__ __forceinline__ float silu(float v) { return v / (1.f + __expf(-v)); }
__device__ __forceinline__ float softplus(float v) { return fmaxf(v, 0.f) + log1pf(__expf(-fabsf(v))); }
__device__ __forceinline__ void unpack8(v4u r, float* f) { f[0] = bf_lo(r.x); f[1] = bf_hi(r.x); f[2] = bf_lo(r.y); f[3] = bf_hi(r.y); f[4] = bf_lo(r.z); f[5] = bf_hi(r.z); f[6] = bf_lo(r.w); f[7] = bf_hi(r.w); }
__device__ __forceinline__ v4u pack8(const float* f) { v4u r; r.x = pk2(f[0], f[1]); r.y = pk2(f[2], f[3]); r.z = pk2(f[4], f[5]); r.w = pk2(f[6], f[7]); return r; }
__device__ __forceinline__ bf16x8 as_frag(v4u r) { return __builtin_bit_cast(bf16x8, r); }
__device__ __forceinline__ f32x4 mfma16(bf16x8 a, bf16x8 b, f32x4 c) { return __builtin_amdgcn_mfma_f32_16x16x32_bf16(a, b, c, 0, 0, 0); }
__device__ __forceinline__ float wave_sum(float v) {
#pragma unroll
    for (int o = 1; o < 64; o <<= 1) v += __shfl_xor(v, o);
    return v;
}
__device__ __forceinline__ float wave_incl_scan(float v, int lane, LAS float* sc, float& tot) {
    sc[lane] = v; asm volatile("s_waitcnt lgkmcnt(0)" ::: "memory");
    float s = 0.f, t = 0.f;
#pragma unroll 8
    for (int k = 0; k < 64; ++k) { const float x = sc[k]; t += x; s += (k <= lane) ? x : 0.f; }
    asm volatile("s_waitcnt lgkmcnt(0)" ::: "memory");
    tot = t; return s;
}
__device__ __forceinline__ void chunk_info(int cgi, int& T, int& t0, int& bg) {
    if (cgi < 64) { T = 2048; t0 = (cgi & 15) * 128; bg = cgi >> 4; } else { const int q = cgi - 64; T = 8192; t0 = (q & 63) * 128; bg = 4 + (q >> 6); }
}
__device__ __forceinline__ int prow(int r) { return r + (r >> 3); }

__device__ __forceinline__ void p0_transpose_item(const float* W, int K, int N, bf16* WT, LAS float* scr, int item, int lane) {
    const int nblk = N / 32, kb = item / nblk, nb = item % nblk, k0 = 64 * kb, n0 = 32 * nb;
    float tv[32];
#pragma unroll
    for (int i = 0; i < 32; ++i) tv[i] = W[(size_t)(k0 + 2 * i + (lane >> 5)) * N + n0 + (lane & 31)];
#pragma unroll
    for (int i = 0; i < 32; ++i) scr[(2 * i + (lane >> 5)) * 33 + (lane & 31)] = tv[i];
    asm volatile("s_waitcnt lgkmcnt(0)" ::: "memory");
    const int c = lane & 7;
#pragma unroll
    for (int j = 0; j < 4; ++j) { const int n = (lane >> 3) + 8 * j; const LAS float* s = scr + (8 * c) * 33 + n;
        v4u o; o.x = pk2(s[0 * 33], s[1 * 33]); o.y = pk2(s[2 * 33], s[3 * 33]); o.z = pk2(s[4 * 33], s[5 * 33]); o.w = pk2(s[6 * 33], s[7 * 33]);
        *(v4u*)(WT + (size_t)(n0 + n) * K + k0 + 8 * c) = o; }
    asm volatile("s_waitcnt lgkmcnt(0)" ::: "memory");
}
template <int NR> __device__ __forceinline__ void rms_rows_to_bf16(const float* const (&xrow)[NR], const float* g, bf16* const (&orow)[NR], int lane) {
    f32x4 v[NR][8];
#pragma unroll
    for (int r = 0; r < NR; ++r) { const f32x4* xr = (const f32x4*)xrow[r] + lane;
#pragma unroll
        for (int j = 0; j < 8; ++j) v[r][j] = __builtin_nontemporal_load(xr + 64 * j); }
    const f32x4* gr = (const f32x4*)g + lane;
#pragma unroll
    for (int r = 0; r < NR; ++r) { float s = 0.f;
#pragma unroll
        for (int j = 0; j < 8; ++j) s += (v[r][j].x * v[r][j].x + v[r][j].y * v[r][j].y) + (v[r][j].z * v[r][j].z + v[r][j].w * v[r][j].w);
        const float rstd = rsqrtf(wave_sum(s) * (1.f / DM) + EPS);
        v2u* o8 = (v2u*)orow[r] + lane;
#pragma unroll
        for (int j = 0; j < 8; ++j) { const f32x4 gg = gr[64 * j]; v2u o; o.x = pk2(v[r][j].x * rstd * gg.x, v[r][j].y * rstd * gg.y); o.y = pk2(v[r][j].z * rstd * gg.z, v[r][j].w * rstd * gg.w); __builtin_nontemporal_store(o, o8 + 64 * j); } }
}
__device__ __forceinline__ void p0_prologue(LAS unsigned char* lds, const Params& P) {
    const int tid = threadIdx.x, lane = tid & 63, wave = tid >> 6;
    LAS float* scr = (LAS float*)(lds + wave * 16384);
    const int gw = blockIdx.x * 8 + wave, NGW = gridDim.x * 8;
    bf16* WinT = (bf16*)(P.ws + WS_WIN); bf16* WoutT = (bf16*)(P.ws + WS_WOUT); bf16* WmemT = (bf16*)(P.ws + WS_WMEM);
    constexpr int I_IN = 32 * (DIN / 32), I_OUT = 32 * (DM / 32), I_MEM = 32 * (1024 / 32);
    for (int it = gw; it < I_IN + I_OUT + I_MEM; it += NGW) {
        int r = it;
        if (r < I_IN) { p0_transpose_item(P.w_in, DM, DIN, WinT, scr, r, lane); continue; } r -= I_IN;
        if (r < I_OUT) { p0_transpose_item(P.w_out, DM, DM, WoutT, scr, r, lane); continue; } r -= I_OUT;
        p0_transpose_item(P.w_mem_kv, DM, 1024, WmemT, scr, r, lane);
    }
    { v4u* z = (v4u*)(WinT + (size_t)DIN * DM); const int nz = (DINP - DIN) * DM / 8; const v4u zero = {0u, 0u, 0u, 0u};
      for (int i = blockIdx.x * 512 + tid; i < nz; i += gridDim.x * 512) z[i] = zero; }
    bf16* XN = (bf16*)((unsigned char*)P.out + OUT_XN); bf16* MEMN = (bf16*)(P.ws + WS_MEMN);
    for (int m4 = gw; m4 < (MTOT + 2048) / 4; m4 += NGW) {
        const int m = m4 * 4; const float* src; const float* gain; bf16* dst;
        if (m < MPROMPT) { src = P.x_prompt + (size_t)m * DM; gain = P.norm_g; dst = XN + (size_t)m * DM; }
        else if (m < MTOT) { src = P.x_sample + (size_t)(m - MPROMPT) * DM; gain = P.norm_g; dst = XN + (size_t)m * DM; }
        else { const int r = m - MTOT; src = r < 1024 ? P.mem_prompt + (size_t)r * DM : P.mem_sample + (size_t)(r - 1024) * DM; gain = P.mem_norm_g; dst = MEMN + (size_t)r * DM; }
        const float* const xr[4] = {src, src + DM, src + 2 * DM, src + 3 * DM}; bf16* const orr[4] = {dst, dst + DM, dst + 2 * DM, dst + 3 * DM};
        rms_rows_to_bf16<4>(xr, gain, orr, lane);
    }
}

struct EpiProj {
    static constexpr bool PERM = true, AFTER_DRAIN = false;
    bf16* O; float* DT;
    __device__ __forceinline__ void operator()(const pg8::f32x4 (&acc)[2][2][4][2], const pg8::Unit& u, int wr, int wc, int fr, int fq) const {
        const int row0 = u.pm * 256 + wr * 64 + fr, col0 = u.pn * 256 + wc * 32 + 8 * fq;
#pragma unroll
        for (int ai = 0; ai < 2; ++ai)
#pragma unroll
            for (int m = 0; m < 4; ++m) { const size_t row = (size_t)(row0 + ai * 128 + m * 16);
#pragma unroll
                for (int bj = 0; bj < 2; ++bj) { const int col = col0 + bj * 128; if (col >= DIN) continue;
                    const pg8::f32x4 v0 = acc[ai][bj][m][0], v1 = acc[ai][bj][m][1];
                    v4u w; w.x = pk2(v0[0], v0[1]); w.y = pk2(v0[2], v0[3]); w.z = pk2(v1[0], v1[1]); w.w = pk2(v1[2], v1[3]);
                    *(v4u*)(O + row * PLD + col) = w;
                    if (col >= C_DT && col < C_DT + 32) { float* d = DT + row * 32 + (col - C_DT); *(f32x4*)d = v0; *(f32x4*)(d + 4) = v1; } } }
    }
};
struct EpiPlain {
    static constexpr bool PERM = true, AFTER_DRAIN = false;
    bf16* O; int ldc;
    __device__ __forceinline__ void operator()(const pg8::f32x4 (&acc)[2][2][4][2], const pg8::Unit& u, int wr, int wc, int fr, int fq) const {
        const int row0 = u.pm * 256 + wr * 64 + fr, col0 = u.pn * 256 + wc * 32 + 8 * fq;
#pragma unroll
        for (int ai = 0; ai < 2; ++ai)
#pragma unroll
            for (int m = 0; m < 4; ++m) { const size_t row = (size_t)(row0 + ai * 128 + m * 16);
#pragma unroll
                for (int bj = 0; bj < 2; ++bj) { const int col = col0 + bj * 128;
                    const pg8::f32x4 v0 = acc[ai][bj][m][0], v1 = acc[ai][bj][m][1];
                    v4u w; w.x = pk2(v0[0], v0[1]); w.y = pk2(v0[2], v0[3]); w.z = pk2(v1[0], v1[1]); w.w = pk2(v1[2], v1[3]);
                    *(v4u*)(O + row * ldc + col) = w; } }
    }
};
struct EpiOut {
    static constexpr bool PERM = false, AFTER_DRAIN = false;
    const float* xp; const float* xs; float* out;
    __device__ __forceinline__ void operator()(const pg8::f32x4 (&acc)[2][2][4][2], const pg8::Unit& u, int wr, int wc, int fr, int fq) const {
        const int row0 = u.pm * 256 + wr * 64 + fr, col0 = u.pn * 256 + wc * 32 + 4 * fq;
        const float* xb = (u.pm < MPROMPT / 256) ? xp : xs - (size_t)MPROMPT * DM;
#pragma unroll
        for (int ai = 0; ai < 2; ++ai)
#pragma unroll
            for (int m = 0; m < 4; ++m) { const size_t off = (size_t)(row0 + ai * 128 + m * 16) * DM + col0;
#pragma unroll
                for (int bj = 0; bj < 2; ++bj)
#pragma unroll
                    for (int n = 0; n < 2; ++n) { const pg8::f32x4 xv = *(const pg8::f32x4*)(xb + off + bj * 128 + n * 16); *(pg8::f32x4*)(out + off + bj * 128 + n * 16) = xv + acc[ai][bj][m][n]; } }
    }
};
struct MemOrder {
    int c, G;
    __device__ bool next(int i, pg8::Unit& u) const { const int cc = (c + G - (128 % G)) % G; const int k = i * G + cc; if (k >= 32) return false; u.pm = k >> 2; u.pn = k & 3; return true; }
    __device__ __forceinline__ void a_ready(const pg8::Unit&) const {}
    __device__ __forceinline__ void done(const pg8::Unit&) const {}
};

__device__ __forceinline__ void conv_run4(const bf16* PROJ, const float* cw, const float* cb, int m0, int t0, int T, int j0, int ch0, bool to_img, LAS bf16* img, int row0, bf16* nat) {
    unsigned xr[8][4];
#pragma unroll
    for (int r = 0; r < 8; ++r) { const int t = t0 + j0 - 2 + r; v4u raw = {0u, 0u, 0u, 0u}; if (t >= 0 && t < T) raw = *(const v4u*)(PROJ + (size_t)(m0 + j0 - 2 + r) * PLD + ch0);
        xr[r][0] = raw.x; xr[r][1] = raw.y; xr[r][2] = raw.z; xr[r][3] = raw.w; }
    unsigned res[4][4];
    float wt[5][8], bs[8];
#pragma unroll
    for (int k = 0; k < 5; ++k) { const f32x4 w0 = *(const f32x4*)(cw + k * 1536 + ch0), w1 = *(const f32x4*)(cw + k * 1536 + ch0 + 4);
        wt[k][0] = w0.x; wt[k][1] = w0.y; wt[k][2] = w0.z; wt[k][3] = w0.w; wt[k][4] = w1.x; wt[k][5] = w1.y; wt[k][6] = w1.z; wt[k][7] = w1.w; }
    { const f32x4 b0 = *(const f32x4*)(cb + ch0), b1 = *(const f32x4*)(cb + ch0 + 4); bs[0] = b0.x; bs[1] = b0.y; bs[2] = b0.z; bs[3] = b0.w; bs[4] = b1.x; bs[5] = b1.y; bs[6] = b1.z; bs[7] = b1.w; }
#pragma unroll
    for (int cp = 0; cp < 4; ++cp) {
        float wl[5], wh[5];
#pragma unroll
        for (int k = 0; k < 5; ++k) { wl[k] = wt[k][2 * cp]; wh[k] = wt[k][2 * cp + 1]; }
        const float bl = bs[2 * cp], bh = bs[2 * cp + 1];
        float al[4], ah[4];
#pragma unroll
        for (int tk = 0; tk < 4; ++tk) { al[tk] = bl; ah[tk] = bh; }
#pragma unroll
        for (int r = 0; r < 8; ++r) { const float xl = bf_lo(xr[r][cp]), xh = bf_hi(xr[r][cp]);
#pragma unroll
            for (int k = 0; k < 5; ++k) { const int tk = r - k; if (tk >= 0 && tk < 4) { al[tk] += wl[k] * xl; ah[tk] += wh[k] * xh; } } }
#pragma unroll
        for (int tk = 0; tk < 4; ++tk) { al[tk] = silu(al[tk]); ah[tk] = silu(ah[tk]); res[tk][cp] = pk2(al[tk], ah[tk]); }
        if (to_img) {
            v2u o; o.x = pk2(al[0], al[1]); o.y = pk2(al[2], al[3]); *(LAS v2u*)(img + prow(row0 + 2 * cp) * 136 + j0) = o;
            o.x = pk2(ah[0], ah[1]); o.y = pk2(ah[2], ah[3]); *(LAS v2u*)(img + prow(row0 + 2 * cp + 1) * 136 + j0) = o;
        }
        __builtin_amdgcn_sched_barrier(0);
    }
    if (nat) {
#pragma unroll
        for (int tk = 0; tk < 4; ++tk) { v4u o; o.x = res[tk][0]; o.y = res[tk][1]; o.z = res[tk][2]; o.w = res[tk][3]; *(v4u*)(nat + tk * 256) = o; }
    }
}
constexpr int TS = 136;
__device__ __forceinline__ void ssd_state_item(LAS unsigned char* lds, const Params& P, int item) {
    const int tid = threadIdx.x, lane = tid & 63, w = tid >> 6, fr = lane & 15, fq = lane >> 4;
    const int cgi = item >> 2, g = (item >> 1) & 1, hq = item & 1;
    int T, t0, bg; chunk_info(cgi, T, t0, bg);
    const int m0 = cgi * 128;
    const bf16* PROJ = (const bf16*)(P.ws + WS_PROJ); const float* DT = (const float*)(P.ws + WS_DT); float* CD = (float*)(P.ws + WS_CD);
    bf16* BN = (bf16*)(P.ws + WS_BN); bf16* CN = (bf16*)(P.ws + WS_CN); bf16* XTg = (bf16*)(P.ws + WS_XT); bf16* ST = (bf16*)(P.ws + WS_ST);
    LAS bf16* XT = (LAS bf16*)lds;
    LAS bf16* BT = XT + 288 * TS;
    LAS float* WF = (LAS float*)(BT + 144 * TS);
    {
        const int dir = w >> 2, hh = w & 3, head = g * 8 + hq * 4 + hh;
        const float bias = P.dt_bias[dir * 16 + head], A = -__expf(P.a_log[dir * 16 + head]);
        const float r0 = DT[(size_t)(m0 + 2 * lane) * 32 + dir * 16 + head], r1 = DT[(size_t)(m0 + 2 * lane + 1) * 32 + dir * 16 + head];
        const float d0 = softplus(r0 + bias), d1 = softplus(r1 + bias), a0 = d0 * A, a1 = d1 * A;
        float tot; const float inc = wave_incl_scan(a0 + a1, lane, WF + 1024 + w * 64, tot);
        const float p1 = inc, p0 = inc - a1;
        float w0, w1;
        if (dir == 0) { w0 = d0 * __expf(tot - p0); w1 = d1 * __expf(tot - p1); }
        else { w0 = d0 * __expf(p0 - a0); w1 = d1 * __expf(p1 - a1); }
        WF[(dir * 4 + hh) * 128 + 2 * lane] = w0; WF[(dir * 4 + hh) * 128 + 2 * lane + 1] = w1;
        if (lane == 0) CD[item * 32 + dir * 4 + hh] = __expf(tot);
    }
#pragma unroll 1
    for (int rnd = 0; rnd < 3 + hq; ++rnd) {
        const bool isx = rnd < 2;
        const int c8 = isx ? (tid & 31) : (tid & 15), j0 = (isx ? (tid >> 5) + 16 * rnd : (tid >> 4)) * 4;
        const int ch0 = isx ? g * 512 + hq * 256 + c8 * 8 : 1024 + (rnd - 2) * 256 + g * 128 + c8 * 8;
        LAS bf16* img = isx ? XT : BT;
        bf16* nat = isx ? (bf16*)nullptr : (rnd == 2 ? (hq == 0 ? BN + (size_t)(m0 + j0) * 256 + g * 128 + c8 * 8 : (bf16*)nullptr) : CN + (size_t)(m0 + j0) * 256 + g * 128 + c8 * 8);
        conv_run4(PROJ, P.conv_w, P.conv_b, m0, t0, T, j0, ch0, rnd < 3, img, c8 * 8, nat);
    }
    __syncthreads();
    for (int q = tid; q < 4096; q += 512) { const int j8 = q & 15, r = q >> 4;
        *(v4u*)(XTg + ((size_t)cgi * 1024 + g * 512 + hq * 256 + r) * 128 + j8 * 8) = *(const LAS v4u*)(XT + prow(r) * TS + j8 * 8); }
    const int hh = w >> 1, dir = w & 1, head = g * 8 + hq * 4 + hh;
    bf16* sp = ST + ((size_t)(cgi * 2 + dir) * 16 + head) * 8192;
#pragma unroll 1
    for (int nh = 0; nh < 2; ++nh) {
        f32x4 acc[4][4];
#pragma unroll
        for (int a = 0; a < 4; ++a)
#pragma unroll
            for (int b = 0; b < 4; ++b) acc[a][b] = (f32x4){0.f, 0.f, 0.f, 0.f};
#pragma unroll 1
        for (int ks = 0; ks < 4; ++ks) {
            const int jb = ks * 32 + 8 * fq;
            bf16x8 bfr[4];
#pragma unroll
            for (int nt = 0; nt < 4; ++nt) bfr[nt] = as_frag(*(const LAS v4u*)(BT + prow(nh * 64 + nt * 16 + fr) * TS + jb));
            float wv[8];
            { const f32x4 a = *(const LAS f32x4*)(WF + (dir * 4 + hh) * 128 + jb), b = *(const LAS f32x4*)(WF + (dir * 4 + hh) * 128 + jb + 4);
              wv[0] = a.x; wv[1] = a.y; wv[2] = a.z; wv[3] = a.w; wv[4] = b.x; wv[5] = b.y; wv[6] = b.z; wv[7] = b.w; }
#pragma unroll
            for (int pt = 0; pt < 4; ++pt) {
                float xv[8]; unpack8(*(const LAS v4u*)(XT + prow(hh * 64 + pt * 16 + fr) * TS + jb), xv);
#pragma unroll
                for (int e = 0; e < 8; ++e) xv[e] *= wv[e];
                const bf16x8 af = as_frag(pack8(xv));
#pragma unroll
                for (int nt = 0; nt < 4; ++nt) acc[pt][nt] = mfma16(bfr[nt], af, acc[pt][nt]);
            }
        }
#pragma unroll
        for (int pt = 0; pt < 4; ++pt)
#pragma unroll
            for (int nt = 0; nt < 4; ++nt) { v2u o; o.x = pk2(acc[pt][nt][0], acc[pt][nt][1]); o.y = pk2(acc[pt][nt][2], acc[pt][nt][3]);
                *(v2u*)(sp + (pt * 16 + fr) * 128 + nh * 64 + nt * 16 + 4 * fq) = o; }
    }
    __syncthreads();
}

__device__ __forceinline__ void transpose8x8_bf16(const v4u (&in)[8], v4u (&out)[8]) {
#pragma unroll
    for (int c2 = 0; c2 < 4; ++c2) {
        unsigned r[8];
#pragma unroll
        for (int k = 0; k < 8; ++k) r[k] = c2 == 0 ? in[k].x : (c2 == 1 ? in[k].y : (c2 == 2 ? in[k].z : in[k].w));
        v4u lo, hi;
        lo.x = __builtin_amdgcn_perm(r[1], r[0], 0x05040100u); lo.y = __builtin_amdgcn_perm(r[3], r[2], 0x05040100u); lo.z = __builtin_amdgcn_perm(r[5], r[4], 0x05040100u); lo.w = __builtin_amdgcn_perm(r[7], r[6], 0x05040100u);
        hi.x = __builtin_amdgcn_perm(r[1], r[0], 0x07060302u); hi.y = __builtin_amdgcn_perm(r[3], r[2], 0x07060302u); hi.z = __builtin_amdgcn_perm(r[5], r[4], 0x07060302u); hi.w = __builtin_amdgcn_perm(r[7], r[6], 0x07060302u);
        out[2 * c2] = lo; out[2 * c2 + 1] = hi;
    }
}
constexpr int WK_ROWS = 416, WK_S = 72, WV_S = 424;
__device__ __forceinline__ void win_attn_item(LAS unsigned char* lds, const Params& P, int item) {
    const int tid = threadIdx.x, lane = tid & 63, w = tid >> 6, fr = lane & 15, fq = lane >> 4;
    const int cgi = item >> 1, kvh = item & 1;
    int T, t0, bg; chunk_info(cgi, T, t0, bg);
    const int m0 = cgi * 128;
    const bf16* PROJ = (const bf16*)(P.ws + WS_PROJ); bf16* CC = (bf16*)(P.ws + WS_CC);
    LAS bf16* Ks = (LAS bf16*)lds;
    LAS bf16* VT = Ks + WK_ROWS * WK_S;
    if (tid < 416) {
        const int ch = tid & 7, j0 = (tid >> 3) * 8;
        const f32x4 g0 = *(const f32x4*)(P.k_norm_g + ch * 8), g1 = *(const f32x4*)(P.k_norm_g + ch * 8 + 4);
        v4u kin[8], vin[8], vout[8];
#pragma unroll
        for (int k = 0; k < 8; ++k) { const int jj = j0 + k, t = t0 - 128 + jj; const bool ok = (jj < 384) && (t >= 0) && (t < T);
            kin[k] = (v4u){0u, 0u, 0u, 0u}; vin[k] = (v4u){0u, 0u, 0u, 0u};
            if (ok) { const bf16* rowp = PROJ + (size_t)(m0 - 128 + jj) * PLD; kin[k] = *(const v4u*)(rowp + C_K + kvh * 64 + ch * 8); vin[k] = *(const v4u*)(rowp + C_V + kvh * 64 + ch * 8); } }
        __builtin_amdgcn_sched_barrier(0);
#pragma unroll
        for (int k = 0; k < 8; ++k) { const int jj = j0 + k; float kv[8];
            unpack8(kin[k], kv);
            float ss = 0.f;
#pragma unroll
            for (int e = 0; e < 8; ++e) ss += kv[e] * kv[e];
            ss += __shfl_xor(ss, 1); ss += __shfl_xor(ss, 2); ss += __shfl_xor(ss, 4);
            const float rstd = rsqrtf(ss * (1.f / 64.f) + EPS);
            kv[0] *= rstd * g0.x; kv[1] *= rstd * g0.y; kv[2] *= rstd * g0.z; kv[3] *= rstd * g0.w; kv[4] *= rstd * g1.x; kv[5] *= rstd * g1.y; kv[6] *= rstd * g1.z; kv[7] *= rstd * g1.w;
            *(LAS v4u*)(Ks + jj * WK_S + ch * 8) = pack8(kv); }
        transpose8x8_bf16(vin, vout);
#pragma unroll
        for (int e = 0; e < 8; ++e) *(LAS v4u*)(VT + prow(ch * 8 + e) * WV_S + j0) = vout[e];
    }
    __syncthreads();
    const int hh = w >> 1, half = w & 1, H = kvh * 4 + hh;
    const float slope = exp2f(-(float)(H + 1)), sink = P.sink[H];
    for (int qt = 0; qt < 4; ++qt) {
        const int i0 = half * 64 + qt * 16;
        bf16x8 qf[2];
        { float q0[8], q1[8]; const bf16* qp = PROJ + (size_t)(m0 + i0 + fr) * PLD + C_Q + H * 64 + 8 * fq;
          unpack8(*(const v4u*)qp, q0); unpack8(*(const v4u*)(qp + 32), q1);
          float ss = 0.f;
#pragma unroll
          for (int e = 0; e < 8; ++e) ss += q0[e] * q0[e] + q1[e] * q1[e];
          ss += __shfl_xor(ss, 16); ss += __shfl_xor(ss, 32);
          const float sc = rsqrtf(ss * (1.f / 64.f) + EPS) * 0.125f;
          const f32x4 ga = *(const f32x4*)(P.q_norm_g + 8 * fq), gb = *(const f32x4*)(P.q_norm_g + 8 * fq + 4), gc = *(const f32x4*)(P.q_norm_g + 32 + 8 * fq), gd = *(const f32x4*)(P.q_norm_g + 32 + 8 * fq + 4);
          q0[0] *= sc * ga.x; q0[1] *= sc * ga.y; q0[2] *= sc * ga.z; q0[3] *= sc * ga.w; q0[4] *= sc * gb.x; q0[5] *= sc * gb.y; q0[6] *= sc * gb.z; q0[7] *= sc * gb.w;
          q1[0] *= sc * gc.x; q1[1] *= sc * gc.y; q1[2] *= sc * gc.z; q1[3] *= sc * gc.w; q1[4] *= sc * gd.x; q1[5] *= sc * gd.y; q1[6] *= sc * gd.z; q1[7] *= sc * gd.w;
          qf[0] = as_frag(pack8(q0)); qf[1] = as_frag(pack8(q1)); }
        f32x4 st[18];
#pragma unroll
        for (int kt = 0; kt < 18; ++kt) {
            f32x4 a = {0.f, 0.f, 0.f, 0.f};
#pragma unroll
            for (int ks = 0; ks < 2; ++ks) a = mfma16(as_frag(*(const LAS v4u*)(Ks + (i0 + kt * 16 + fr) * WK_S + ks * 32 + 8 * fq)), qf[ks], a);
            st[kt] = a;
        }
        const int iq = i0 + fr + 128;
        float mx = sink;
#pragma unroll
        for (int kt = 0; kt < 18; ++kt)
#pragma unroll
            for (int r = 0; r < 4; ++r) { const int jj = i0 + kt * 16 + 4 * fq + r, t = t0 - 128 + jj; int dist = iq - jj; dist = dist < 0 ? -dist : dist;
                const bool ok = (dist <= 128) && (t >= 0) && (t < T);
                const float lg = ok ? st[kt][r] - slope * (float)dist : -INFINITY; st[kt][r] = lg; mx = fmaxf(mx, lg); }
        mx = fmaxf(mx, __shfl_xor(mx, 16)); mx = fmaxf(mx, __shfl_xor(mx, 32));
        float sum = 0.f;
#pragma unroll
        for (int kt = 0; kt < 18; ++kt)
#pragma unroll
            for (int r = 0; r < 4; ++r) { const float p = __expf(st[kt][r] - mx); st[kt][r] = p; sum += p; }
        sum += __shfl_xor(sum, 16); sum += __shfl_xor(sum, 32);
        const float inv = 1.f / (sum + __expf(sink - mx));
        f32x4 ot[4];
#pragma unroll
        for (int dt = 0; dt < 4; ++dt) ot[dt] = (f32x4){0.f, 0.f, 0.f, 0.f};
#pragma unroll
        for (int kk = 0; kk < 9; ++kk) {
            v4u pb; pb.x = pk2(st[2 * kk][0], st[2 * kk][1]); pb.y = pk2(st[2 * kk][2], st[2 * kk][3]); pb.z = pk2(st[2 * kk + 1][0], st[2 * kk + 1][1]); pb.w = pk2(st[2 * kk + 1][2], st[2 * kk + 1][3]);
#pragma unroll
            for (int dt = 0; dt < 4; ++dt) { const LAS bf16* vp = VT + prow(dt * 16 + fr) * WV_S + i0 + 32 * kk + 4 * fq;
                const v2u lo = *(const LAS v2u*)vp, hi = *(const LAS v2u*)(vp + 16); v4u va; va.x = lo.x; va.y = lo.y; va.z = hi.x; va.w = hi.y;
                ot[dt] = mfma16(as_frag(va), as_frag(pb), ot[dt]); }
        }
        const size_t row = (size_t)(m0 + i0 + fr);
#pragma unroll
        for (int dt = 0; dt < 4; ++dt) { const int d = H * 64 + dt * 16 + 4 * fq; const v2u z = *(const v2u*)(PROJ + row * PLD + C_ZATT + d);
            v2u o; o.x = pk2(ot[dt][0] * inv * silu(bf_lo(z.x)), ot[dt][1] * inv * silu(bf_hi(z.x))); o.y = pk2(ot[dt][2] * inv * silu(bf_lo(z.y)), ot[dt][3] * inv * silu(bf_hi(z.y)));
            if (EXPT == 2) { o.x = 0u; o.y = 0u; } *(v2u*)(CC + row * DM + 1024 + d) = o; }
    }
    __syncthreads();
}

constexpr int MK_S = 136, MV_S = 264;
__device__ __forceinline__ void mem_attn_item(LAS unsigned char* lds, const Params& P, int item) {
    const int tid = threadIdx.x, lane = tid & 63, w = tid >> 6, fr = lane & 15, fq = lane >> 4;
    const int cgi = item >> 2, hm = item & 3;
    int T, t0, bg; chunk_info(cgi, T, t0, bg);
    const int m0 = cgi * 128;
    const bf16* PROJ = (const bf16*)(P.ws + WS_PROJ); const bf16* MKV = (const bf16*)(P.ws + WS_MKV); bf16* CC = (bf16*)(P.ws + WS_CC);
    LAS bf16* MKs = (LAS bf16*)lds;
    LAS bf16* MVT = MKs + 256 * MK_S;
    {
        const int ch = tid & 15, j0 = (tid >> 4) * 8;
        const f32x4 g0 = *(const f32x4*)(P.mk_norm_g + ch * 8), g1 = *(const f32x4*)(P.mk_norm_g + ch * 8 + 4);
        v4u kin[8], vin[8], vout[8];
#pragma unroll
        for (int k = 0; k < 8; ++k) { const bf16* rowp = MKV + (size_t)(bg * 256 + j0 + k) * 1024 + hm * 128 + ch * 8; kin[k] = *(const v4u*)rowp; vin[k] = *(const v4u*)(rowp + 512); }
        __builtin_amdgcn_sched_barrier(0);
#pragma unroll
        for (int k = 0; k < 8; ++k) { const int mm = j0 + k; float kv[8];
            unpack8(kin[k], kv);
            float ss = 0.f;
#pragma unroll
            for (int e = 0; e < 8; ++e) ss += kv[e] * kv[e];
            ss += __shfl_xor(ss, 1); ss += __shfl_xor(ss, 2); ss += __shfl_xor(ss, 4); ss += __shfl_xor(ss, 8);
            const float rstd = rsqrtf(ss * (1.f / 128.f) + EPS);
            kv[0] *= rstd * g0.x; kv[1] *= rstd * g0.y; kv[2] *= rstd * g0.z; kv[3] *= rstd * g0.w; kv[4] *= rstd * g1.x; kv[5] *= rstd * g1.y; kv[6] *= rstd * g1.z; kv[7] *= rstd * g1.w;
            *(LAS v4u*)(MKs + mm * MK_S + ch * 8) = pack8(kv); }
        transpose8x8_bf16(vin, vout);
#pragma unroll
        for (int e = 0; e < 8; ++e) *(LAS v4u*)(MVT + prow(ch * 8 + e) * MV_S + j0) = vout[e];
    }
    __syncthreads();
    const int i0 = w * 16;
    bf16x8 qf[4];
    { float qv[4][8]; const bf16* qp = PROJ + (size_t)(m0 + i0 + fr) * PLD + C_MQ + hm * 128 + 8 * fq; float ss = 0.f;
#pragma unroll
      for (int ks = 0; ks < 4; ++ks) { unpack8(*(const v4u*)(qp + ks * 32), qv[ks]);
#pragma unroll
          for (int e = 0; e < 8; ++e) ss += qv[ks][e] * qv[ks][e]; }
      ss += __shfl_xor(ss, 16); ss += __shfl_xor(ss, 32);
      const float sc = rsqrtf(ss * (1.f / 128.f) + EPS) * 0.08838834764831845f;
#pragma unroll
      for (int ks = 0; ks < 4; ++ks) { const f32x4 ga = *(const f32x4*)(P.mq_norm_g + ks * 32 + 8 * fq), gb = *(const f32x4*)(P.mq_norm_g + ks * 32 + 8 * fq + 4);
          qv[ks][0] *= sc * ga.x; qv[ks][1] *= sc * ga.y; qv[ks][2] *= sc * ga.z; qv[ks][3] *= sc * ga.w; qv[ks][4] *= sc * gb.x; qv[ks][5] *= sc * gb.y; qv[ks][6] *= sc * gb.z; qv[ks][7] *= sc * gb.w;
          qf[ks] = as_frag(pack8(qv[ks])); } }
    f32x4 st[16];
#pragma unroll
    for (int kt = 0; kt < 16; ++kt) {
        f32x4 a = {0.f, 0.f, 0.f, 0.f};
#pragma unroll
        for (int ks = 0; ks < 4; ++ks) a = mfma16(as_frag(*(const LAS v4u*)(MKs + (kt * 16 + fr) * MK_S + ks * 32 + 8 * fq)), qf[ks], a);
        st[kt] = a;
    }
    float mx = -INFINITY;
#pragma unroll
    for (int kt = 0; kt < 16; ++kt)
#pragma unroll
        for (int r = 0; r < 4; ++r) mx = fmaxf(mx, st[kt][r]);
    mx = fmaxf(mx, __shfl_xor(mx, 16)); mx = fmaxf(mx, __shfl_xor(mx, 32));
    float sum = 0.f;
#pragma unroll
    for (int kt = 0; kt < 16; ++kt)
#pragma unroll
        for (int r = 0; r < 4; ++r) { const float p = __expf(st[kt][r] - mx); st[kt][r] = p; sum += p; }
    sum += __shfl_xor(sum, 16); sum += __shfl_xor(sum, 32);
    const float inv = 1.f / sum;
    f32x4 ot[8];
#pragma unroll
    for (int dt = 0; dt < 8; ++dt) ot[dt] = (f32x4){0.f, 0.f, 0.f, 0.f};
#pragma unroll
    for (int kk = 0; kk < 8; ++kk) {
        v4u pb; pb.x = pk2(st[2 * kk][0], st[2 * kk][1]); pb.y = pk2(st[2 * kk][2], st[2 * kk][3]); pb.z = pk2(st[2 * kk + 1][0], st[2 * kk + 1][1]); pb.w = pk2(st[2 * kk + 1][2], st[2 * kk + 1][3]);
#pragma unroll
        for (int dt = 0; dt < 8; ++dt) { const LAS bf16* vp = MVT + prow(dt * 16 + fr) * MV_S + 32 * kk + 4 * fq;
            const v2u lo = *(const LAS v2u*)vp, hi = *(const LAS v2u*)(vp + 16); v4u va; va.x = lo.x; va.y = lo.y; va.z = hi.x; va.w = hi.y;
            ot[dt] = mfma16(as_frag(va), as_frag(pb), ot[dt]); }
    }
    const size_t row = (size_t)(m0 + i0 + fr);
#pragma unroll
    for (int dt = 0; dt < 8; ++dt) { const int d = hm * 128 + dt * 16 + 4 * fq; const v2u z = *(const v2u*)(PROJ + row * PLD + C_ZMEM + d);
        v2u o; o.x = pk2(ot[dt][0] * inv * silu(bf_lo(z.x)), ot[dt][1] * inv * silu(bf_hi(z.x))); o.y = pk2(ot[dt][2] * inv * silu(bf_lo(z.y)), ot[dt][3] * inv * silu(bf_hi(z.y)));
        if (EXPT == 2) { o.x = 0u; o.y = 0u; } *(v2u*)(CC + row * DM + 1536 + d) = o; }
    __syncthreads();
}

__device__ __forceinline__ void scan_phase(const Params& P) {
    const bf16* ST = (const bf16*)(P.ws + WS_ST); bf16* SP = (bf16*)((unsigned char*)P.out + OUT_SP); const float* CD = (const float*)(P.ws + WS_CD);
    for (int idx = blockIdx.x * 512 + threadIdx.x; idx < 262144; idx += gridDim.x * 512) {
        const int n8 = idx & 15, p = (idx >> 4) & 63, h = (idx >> 10) & 15, dir = (idx >> 14) & 1, bgi = idx >> 15;
        const int cg0 = bgi < 4 ? bgi * 16 : 64 + (bgi - 4) * 64, nc = bgi < 4 ? 16 : 64;
        float S[8];
#pragma unroll
        for (int e = 0; e < 8; ++e) S[e] = 0.f;
        for (int s0 = 0; s0 < nc; s0 += 4) {
            v4u raw[4]; float cd[4]; size_t off[4];
#pragma unroll
            for (int u = 0; u < 4; ++u) { const int c = dir ? nc - 1 - (s0 + u) : s0 + u, cgi = cg0 + c;
                off[u] = (((size_t)(cgi * 2 + dir) * 16 + h) * 64 + p) * 128 + n8 * 8; raw[u] = *(const v4u*)(ST + off[u]); cd[u] = CD[(cgi * 4 + (h >> 2)) * 32 + dir * 4 + (h & 3)]; }
#pragma unroll
            for (int u = 0; u < 4; ++u) { float st[8]; unpack8(raw[u], st); *(v4u*)(SP + off[u]) = pack8(S);
#pragma unroll
                for (int e = 0; e < 8; ++e) S[e] = cd[u] * S[e] + st[e]; }
        }
    }
}

__device__ __forceinline__ void ssd_y_item(LAS unsigned char* lds, const Params& P, int item) {
    const int tid = threadIdx.x, lane = tid & 63, w = __builtin_amdgcn_readfirstlane(tid >> 6), fr = lane & 15, fq = lane >> 4;
    const int cgi = item >> 1, g = item & 1, head = g * 8 + w;
    const int m0 = cgi * 128;
    const bf16* PROJ = (const bf16*)(P.ws + WS_PROJ); const float* DT = (const float*)(P.ws + WS_DT);
    const bf16* BN = (const bf16*)(P.ws + WS_BN); const bf16* CN = (const bf16*)(P.ws + WS_CN); const bf16* XTg = (const bf16*)(P.ws + WS_XT); const bf16* ST = (const bf16*)((const unsigned char*)P.out + OUT_SP);
    bf16* CC = (bf16*)(P.ws + WS_CC);
    LAS bf16* Cs = (LAS bf16*)lds;
    LAS bf16* CBs = Cs + 128 * TS;
    LAS bf16* Bs = CBs + 128 * TS;
    LAS float* PF = (LAS float*)(Bs + 128 * TS);
    LAS float* RB = PF + 1024;
    LAS float* DF = RB + 1024;
    LAS float* DB = DF + 1024;
    LAS float* SQ = DB + 1024;
    LAS float* RS = SQ + 2048;
    LAS float* SCR = RS + 128;
    {
#pragma unroll
        for (int dir = 0; dir < 2; ++dir) {
            const float bias = P.dt_bias[dir * 16 + head], A = -__expf(P.a_log[dir * 16 + head]);
            const float r0 = DT[(size_t)(m0 + 2 * lane) * 32 + dir * 16 + head], r1 = DT[(size_t)(m0 + 2 * lane + 1) * 32 + dir * 16 + head];
            const float d0 = softplus(r0 + bias), d1 = softplus(r1 + bias), a0 = d0 * A, a1 = d1 * A;
            float tot; const float inc = wave_incl_scan(a0 + a1, lane, SCR + w * 64, tot);
            const float p1 = inc, p0 = inc - a1;
            if (dir == 0) { PF[w * 128 + 2 * lane] = p0; PF[w * 128 + 2 * lane + 1] = p1; DF[w * 128 + 2 * lane] = d0; DF[w * 128 + 2 * lane + 1] = d1; }
            else { RB[w * 128 + 2 * lane] = tot - p0 + a0; RB[w * 128 + 2 * lane + 1] = tot - p1 + a1; DB[w * 128 + 2 * lane] = d0; DB[w * 128 + 2 * lane + 1] = d1; }
        }
    }
    for (int q = tid; q < 4096; q += 512) { const int qq = q & 2047, c8 = qq & 15, j = qq >> 4;
        if (q < 2048) *(LAS v4u*)(Cs + j * TS + c8 * 8) = *(const v4u*)(CN + (size_t)(m0 + j) * 256 + g * 128 + c8 * 8);
        else *(LAS v4u*)(Bs + j * TS + c8 * 8) = *(const v4u*)(BN + (size_t)(m0 + j) * 256 + g * 128 + c8 * 8); }
    __syncthreads();
    {
        f32x4 cb[8];
#pragma unroll
        for (int jt = 0; jt < 8; ++jt) cb[jt] = (f32x4){0.f, 0.f, 0.f, 0.f};
#pragma unroll
        for (int ks = 0; ks < 4; ++ks) { const bf16x8 a = as_frag(*(const LAS v4u*)(Cs + (w * 16 + fr) * TS + ks * 32 + 8 * fq));
#pragma unroll
            for (int jt = 0; jt < 8; ++jt) cb[jt] = mfma16(a, as_frag(*(const LAS v4u*)(Bs + (jt * 16 + fr) * TS + ks * 32 + 8 * fq)), cb[jt]); }
#pragma unroll
        for (int jt = 0; jt < 8; ++jt)
#pragma unroll
            for (int r = 0; r < 4; ++r) CBs[(w * 16 + 4 * fq + r) * TS + jt * 16 + fr] = f2bf(cb[jt][r]);
    }
    __syncthreads();
    const float Dh = P.d_skip[head];
    const char* SpF = (const char*)(ST + ((size_t)(cgi * 2 + 0) * 16 + head) * 8192); const char* SpB = SpF + (size_t)16 * 8192 * 2;
    const char* Xp = (const char*)(XTg + ((size_t)cgi * 1024 + head * 64) * 128);
#define LD8(dst, arr) do { const f32x4 _a = *(const LAS f32x4*)((arr) + w * 128 + jb), _b = *(const LAS f32x4*)((arr) + w * 128 + jb + 4); \
        dst[0] = _a.x; dst[1] = _a.y; dst[2] = _a.z; dst[3] = _a.w; dst[4] = _b.x; dst[5] = _b.y; dst[6] = _b.z; dst[7] = _b.w; } while (0)
#pragma unroll 1
    for (int ph = 0; ph < 2; ++ph) {
        f32x4 acc[8][2];
#pragma unroll
        for (int it = 0; it < 8; ++it) { acc[it][0] = (f32x4){0.f, 0.f, 0.f, 0.f}; acc[it][1] = (f32x4){0.f, 0.f, 0.f, 0.f}; }
        const unsigned vo0 = (unsigned)((((2 * ph) * 16 + fr) * 128 + 8 * fq) * 2), vo1 = vo0 + 16 * 128 * 2;
#pragma unroll 1
        for (int s = 0; s < 8; ++s) {
            const int ks = s & 3, jb = ks * 32 + 8 * fq; const char* base = (s < 4 ? SpF : SpB) + ks * 64;
            unsigned va = vo0, vb = vo1; asm volatile("" : "+v"(va), "+v"(vb));
            const bf16x8 f0 = as_frag(*(const v4u*)(base + va)), f1 = as_frag(*(const v4u*)(base + vb));
            const LAS float* cum = (s < 4 ? PF : RB) + w * 128;
#pragma unroll
            for (int it = 0; it < 8; ++it) { const int i = it * 16 + fr; const float sc = __expf(cum[i]); float cv[8]; unpack8(*(const LAS v4u*)(Cs + i * TS + jb), cv);
#pragma unroll
                for (int e = 0; e < 8; ++e) cv[e] *= sc;
                const bf16x8 a = as_frag(pack8(cv));
                acc[it][0] = mfma16(f0, a, acc[it][0]); acc[it][1] = mfma16(f1, a, acc[it][1]); }
        }
#pragma unroll 1
        for (int ks = 0; ks < 4; ++ks) {
            const int jb = ks * 32 + 8 * fq; const char* base = Xp + ks * 64;
            unsigned va = vo0, vb = vo1; asm volatile("" : "+v"(va), "+v"(vb));
            const bf16x8 f0 = as_frag(*(const v4u*)(base + va)), f1 = as_frag(*(const v4u*)(base + vb));
            const float pref = PF[w * 128 + ks * 32 + 31], rref = RB[w * 128 + ks * 32];
#pragma unroll
            for (int it = 0; it < 8; ++it) { const int i = it * 16 + fr; const float pi = PF[w * 128 + i], ri = RB[w * 128 + i];
                const int rel = it * 16 - ks * 32;
                float cv[8]; unpack8(*(const LAS v4u*)(CBs + i * TS + jb), cv);
                if (rel >= 32) { const float ei = __expf(fminf(pi - pref, 0.f)); float pj[8], dfj[8]; LD8(pj, PF); LD8(dfj, DF);
#pragma unroll
                    for (int e = 0; e < 8; ++e) cv[e] *= ei * (__expf(fminf(pref - pj[e], 0.f)) * dfj[e]); }
                else if (rel <= -16) { const float ei = __expf(fminf(ri - rref, 0.f)); float rj[8], dbj[8]; LD8(rj, RB); LD8(dbj, DB);
#pragma unroll
                    for (int e = 0; e < 8; ++e) cv[e] *= ei * (__expf(fminf(rref - rj[e], 0.f)) * dbj[e]); }
                else { float tf[8]; const float dsum = DF[w * 128 + i] + DB[w * 128 + i];
                    { float pj[8], dfj[8]; LD8(pj, PF); LD8(dfj, DF);
#pragma unroll
                      for (int e = 0; e < 8; ++e) tf[e] = __expf(fminf(pi - pj[e], 0.f)) * dfj[e]; }
                    __builtin_amdgcn_sched_barrier(0);
                    { float rj[8], dbj[8]; LD8(rj, RB); LD8(dbj, DB);
#pragma unroll
                      for (int e = 0; e < 8; ++e) { const int j = jb + e; const float eb = __expf(fminf(ri - rj[e], 0.f)) * dbj[e];
                          const float m = j < i ? tf[e] : (j > i ? eb : dsum); cv[e] = cv[e] * m + (j == i ? Dh : 0.f); } } }
                const bf16x8 a = as_frag(pack8(cv));
                acc[it][0] = mfma16(f0, a, acc[it][0]); acc[it][1] = mfma16(f1, a, acc[it][1]);
                __builtin_amdgcn_sched_barrier(0); }
        }
        char* cb2 = (char*)(CC + (size_t)m0 * DM + head * 64 + ph * 32);
#pragma unroll
        for (int it = 0; it < 8; ++it) { unsigned vc = (unsigned)(((it * 16 + fr) * DM + 4 * fq) * 2); asm volatile("" : "+v"(vc));
#pragma unroll
            for (int ptl = 0; ptl < 2; ++ptl) { v2u o; o.x = pk2(acc[it][ptl][0], acc[it][ptl][1]); o.y = pk2(acc[it][ptl][2], acc[it][ptl][3]); *(v2u*)(cb2 + vc + ptl * 32) = o; } }
    }
#undef LD8
    asm volatile("s_waitcnt vmcnt(0)" ::: "memory");
    __syncthreads();
    {
        const f32x4 g0 = *(const f32x4*)(P.ssd_norm_g + g * 512 + lane * 8), g1 = *(const f32x4*)(P.ssd_norm_g + g * 512 + lane * 8 + 4);
        bf16* crow = CC + (size_t)(m0 + w * 16) * DM + g * 512 + lane * 8; const bf16* zrow = PROJ + (size_t)(m0 + w * 16) * PLD + C_ZSSD + g * 512 + lane * 8;
#pragma unroll 1
        for (int kb = 0; kb < 2; ++kb) {
            v4u yv[8], zv[8];
#pragma unroll
            for (int k = 0; k < 8; ++k) { yv[k] = __builtin_nontemporal_load((const v4u*)(crow + (size_t)(kb * 8 + k) * DM)); zv[k] = *(const v4u*)(zrow + (size_t)(kb * 8 + k) * PLD); }
#pragma unroll
            for (int k = 0; k < 8; ++k) { float y[8], z[8]; unpack8(yv[k], y); unpack8(zv[k], z); float s = 0.f;
#pragma unroll
                for (int e = 0; e < 8; ++e) { y[e] *= silu(z[e]); s += y[e] * y[e]; }
                const float rs = rsqrtf(wave_sum(s) * (1.f / 512.f) + EPS);
                y[0] *= rs * g0.x; y[1] *= rs * g0.y; y[2] *= rs * g0.z; y[3] *= rs * g0.w; y[4] *= rs * g1.x; y[5] *= rs * g1.y; y[6] *= rs * g1.z; y[7] *= rs * g1.w;
                v4u o = pack8(y); if (EXPT == 1) o = (v4u){0u, 0u, 0u, 0u};
                *(v4u*)(crow + (size_t)(kb * 8 + k) * DM) = o; }
        }
    }
    __syncthreads();
}

#define RLX_AGENT __ATOMIC_RELAXED, __HIP_MEMORY_SCOPE_AGENT
#define XB_TMO      128
#define XB_XCNT(j)  (256  + 64 * (j))
#define XB_XSUB(j)  (1280 + 64 * (j))
#define XB_XGEN(j)  (2304 + 64 * (j))
#define XB_TOP      3328
#define XB_TOPGEN   3392
#define XCD_BAR_WORDS 3456
#define XB_SPIN_CAP (1u << 18)

__device__ __forceinline__ unsigned xb_ld(unsigned* p)              { return __hip_atomic_load(p, __ATOMIC_RELAXED, __HIP_MEMORY_SCOPE_AGENT); }
__device__ __forceinline__ unsigned xb_add(unsigned* p, unsigned v) { return __hip_atomic_fetch_add(p, v, __ATOMIC_RELAXED, __HIP_MEMORY_SCOPE_AGENT); }
__device__ __forceinline__ unsigned xb_xcc_id() { return (unsigned)__builtin_amdgcn_s_getreg((3 << 11) | 20) & 0xFu; }
#define XB_SPIN(cond, bar) do { unsigned _sp = 0; while (cond) { __builtin_amdgcn_s_sleep(1); \
    if ((++_sp & 255u) == 0u) { if (xb_ld(&(bar)[XB_TMO])) break; if (_sp > XB_SPIN_CAP) { atomicAdd(&(bar)[XB_TMO], 1u); break; } } } } while (0)

struct XcdBarrier {
    unsigned* bar; unsigned x;
    volatile LAS unsigned* st;
};

__device__ __forceinline__ XcdBarrier xcd_barrier_post(unsigned* bar, volatile LAS unsigned* st) {
    XcdBarrier b; b.bar = bar; b.x = xb_xcc_id(); b.st = st;
    if (threadIdx.x == 0) (void)xb_add(&bar[XB_XCNT(b.x)], 1u);
    return b;
}
__device__ __forceinline__ void xcd_barrier_complete(unsigned* bar, unsigned x, unsigned& nloc, unsigned& nx) {
    const unsigned G = gridDim.x * gridDim.y * gridDim.z;
    unsigned sum, cnt, mine, sp = 0u;
    for (;;) {
        sum = 0u; cnt = 0u; mine = 0u;
#pragma unroll
        for (unsigned j = 0; j < 16; ++j) { const unsigned c = xb_ld(&bar[XB_XCNT(j)]); sum += c; cnt += (c > 0u) ? 1u : 0u; mine = (j == x) ? c : mine; }
        if (sum == G) break;
        __builtin_amdgcn_s_sleep(1);
        if ((++sp & 255u) == 0u) { if (xb_ld(&bar[XB_TMO])) break; if (sp > XB_SPIN_CAP) { atomicAdd(&bar[XB_TMO], 1u); break; } }
    }
    nloc = mine > 0u ? mine : 1u; nx = cnt > 0u ? cnt : 1u;
}

__device__ __forceinline__ void xcd_barrier(const XcdBarrier& b) {
    asm volatile("s_waitcnt vmcnt(0)" ::: "memory");
    __syncthreads();
    if (threadIdx.x == 0) {
        unsigned* bar = b.bar;
        __builtin_amdgcn_s_waitcnt(0);
        unsigned nloc = b.st[0], nx = b.st[1];
        if (nloc == 0u) { xcd_barrier_complete(bar, b.x, nloc, nx); b.st[0] = nloc; b.st[1] = nx; }
        const unsigned old = xb_add(&bar[XB_XSUB(b.x)], 1u);
        const unsigned gen = old / nloc;
        if (old + 1u == (gen + 1u) * nloc) {
            __builtin_amdgcn_fence(__ATOMIC_RELEASE, "agent");
            asm volatile("s_waitcnt vmcnt(0)" ::: "memory");
            const unsigned og = xb_add(&bar[XB_TOP], 1u);
            const unsigned tg = og / nx;
            if (og + 1u == (tg + 1u) * nx) xb_add(&bar[XB_TOPGEN], 1u);
            else XB_SPIN(xb_ld(&bar[XB_TOPGEN]) == tg, bar);
            __builtin_amdgcn_fence(__ATOMIC_ACQUIRE, "agent");
            xb_add(&bar[XB_XGEN(b.x)], 1u);
            asm volatile("s_waitcnt vmcnt(0)" ::: "memory");
        } else {
            XB_SPIN(xb_ld(&bar[XB_XGEN(b.x)]) == gen, bar);
            __builtin_amdgcn_fence(__ATOMIC_ACQUIRE, "agent");
            asm volatile("s_waitcnt vmcnt(0)" ::: "memory");
        }
    }
    __syncthreads();
}

__global__ void __launch_bounds__(512, 2) hymba_fwd(Params P) {
    extern __shared__ __attribute__((aligned(16))) unsigned char lds_raw[];
    LAS unsigned char* lds = (LAS unsigned char*)lds_raw;
    if (P.ws == nullptr) cg::this_grid().sync();
    if (threadIdx.x < 8) ((LAS unsigned*)(lds + LDS_BYTES - 32))[threadIdx.x] = 0u;
    __syncthreads();
    XcdBarrier bar = xcd_barrier_post((unsigned*)(P.ws + WS_BAR), (volatile LAS unsigned*)(lds + LDS_BYTES - 32));
#define GRID_SYNC() xcd_barrier(bar)
    const int G = gridDim.x, c = blockIdx.x;

    p0_prologue(lds, P);
    GRID_SYNC();

    {
        pg8::Gemm g1{(const bf16*)((const unsigned char*)P.out + OUT_XN), (const bf16*)(P.ws + WS_WIN), MTOT, DINP, DM}; pg8::StaticOrder S1; S1.init(MTOT, DINP, G, c);
        EpiProj E1{(bf16*)(P.ws + WS_PROJ), (float*)(P.ws + WS_DT)};
        pg8::gemm_phase<EpiProj, pg8::StaticOrder, true, true>(lds, g1, S1, E1);
        pg8::Gemm g2{(const bf16*)(P.ws + WS_MEMN), (const bf16*)(P.ws + WS_WMEM), 2048, 1024, DM}; MemOrder S2{c, G};
        EpiPlain E2{(bf16*)(P.ws + WS_MKV), 1024};
        pg8::gemm_phase<EpiPlain, MemOrder, true, true>(lds, g2, S2, E2);
    }
    GRID_SYNC();

    unsigned* ctr = (unsigned*)P.ws;
    LAS volatile int* slot = (LAS volatile int*)(lds + LDS_BYTES - 16);
#define RUN_QUEUE(CTR, NITEMS, BODY) do { \
        int it_; if (threadIdx.x == 0) slot[0] = (int)__hip_atomic_fetch_add((CTR), 1u, __ATOMIC_RELAXED, __HIP_MEMORY_SCOPE_AGENT); \
        __syncthreads(); it_ = slot[0]; __syncthreads(); \
        while (it_ < (NITEMS)) { \
            int nxt_ = 0; if (threadIdx.x == 0) nxt_ = (int)__hip_atomic_fetch_add((CTR), 1u, __ATOMIC_RELAXED, __HIP_MEMORY_SCOPE_AGENT); \
            { const int it = it_; BODY } \
            if (threadIdx.x == 0) slot[0] = nxt_; \
            __syncthreads(); it_ = slot[0]; __syncthreads(); \
        } } while (0)
    RUN_QUEUE(ctr, 1920, if (it < 640) win_attn_item(lds, P, it); else ssd_state_item(lds, P, it - 640););
    GRID_SYNC();

    scan_phase(P);
    GRID_SYNC();

    RUN_QUEUE(ctr + 64, 640, ssd_y_item(lds, P, it););
    RUN_QUEUE(ctr + 128, 1280, mem_attn_item(lds, P, it););
    GRID_SYNC();
#undef RUN_QUEUE

    {
        pg8::Gemm g5{(const bf16*)(P.ws + WS_CC), (const bf16*)(P.ws + WS_WOUT), MTOT, DM, DM}; pg8::StaticOrder S5; S5.init(MTOT, DM, G, c);
        EpiOut E5{P.x_prompt, P.x_sample, P.out};
        pg8::gemm_phase<EpiOut, pg8::StaticOrder, true, true>(lds, g5, S5, E5);
    }
}

extern "C" void kernel_launch(void* const* d_in, const int* in_sizes, int n_in, void* d_out, int out_size, void* d_ws, size_t ws_size, hipStream_t stream) {
    static int grid = 0;
    if (grid == 0) {
        if (n_in != 20 || out_size != MTOT * DM || ws_size < WS_END) { fprintf(stderr, "kernel_launch: unexpected problem (n_in %d, out %d, ws %zu)\n", n_in, out_size, ws_size); grid = -1; return; }
        int dev = 0, cus = 0, per_cu = 0;
        hipGetDevice(&dev); hipDeviceGetAttribute(&cus, hipDeviceAttributeMultiprocessorCount, dev);
        if (hipFuncSetAttribute((const void*)hymba_fwd, hipFuncAttributeMaxDynamicSharedMemorySize, LDS_BYTES) != hipSuccess) { fprintf(stderr, "kernel_launch: hipFuncSetAttribute failed\n"); grid = -1; return; }
        if (hipOccupancyMaxActiveBlocksPerMultiprocessor(&per_cu, (const void*)hymba_fwd, 512, LDS_BYTES) != hipSuccess || per_cu < 1) { fprintf(stderr, "kernel_launch: occupancy query says %d\n", per_cu); per_cu = 1; }
        (void)hipGetLastError();
        grid = cus;
    }
    if (grid < 0) return;
    if (hipMemsetAsync(d_ws, 0, WS_CTL_BYTES, stream) != hipSuccess) { fprintf(stderr, "kernel_launch: hipMemsetAsync failed\n"); return; }
    Params p{};
    const float** f = (const float**)&p;
    for (int i = 0; i < 20; ++i) f[i] = (const float*)d_in[i];
    p.out = (float*)d_out; p.ws = (unsigned char*)d_ws;
    void* args[] = {&p};
    hipError_t e = hipLaunchCooperativeKernel((const void*)hymba_fwd, dim3(grid), dim3(512), args, LDS_BYTES, stream);
    if (e != hipSuccess) fprintf(stderr, "cooperative launch failed: %s (grid %d)\n", hipGetErrorString(e), grid);
}
```

```cpp
#include <hip/hip_runtime.h>
#include <hip/hip_cooperative_groups.h>
#include <cstdio>
#include <cstdint>
namespace cg = cooperative_groups;
namespace pg8 {
#define PG8_LAS __attribute__((address_space(3)))
typedef unsigned short bf16_t;
typedef short bf16x8 __attribute__((ext_vector_type(8)));
typedef float f32x4 __attribute__((ext_vector_type(4)));
typedef unsigned u32x4 __attribute__((ext_vector_type(4)));
constexpr int BM = 256, BK = 64, HALF = 128, HTB = HALF * BK * 2  , STAGE_BYTES = 8 * HTB, NXCD = 8, WGM = 8;

__host__ __device__ __forceinline__ int lds_byte(int r, int c) { const int st = (r >> 4) * 2 + (c >> 5), rr = r & 15, cc = c & 31, ob = rr * 64 + cc * 2; return st * 1024 + (ob ^ (((ob >> 9) & 1) << 5)); }
__host__ __device__ __forceinline__ void stage_rc(int b, int& R, int& C) { const int st = b / 1024, sb = b % 1024, swz = sb ^ (((sb >> 9) & 1) << 5); R = (st >> 1) * 16 + swz / 64; C = (st & 1) * 32 + (swz % 64) / 2; }
__host__ __device__ __forceinline__ int perm32(int rho) { const int n = rho >> 4, i = rho & 15; return 8 * (i >> 2) + 4 * n + (i & 3); }

struct Unit { int pm, pn; };
struct Gemm { const bf16_t* A; const bf16_t* Bt; int M, N, K; };

struct StaticOrder {
    int nM, nN, nwg, G, c;
    __host__ __device__ void init(int M, int N, int G_, int c_) { nM = M / BM; nN = N / BM; nwg = nM * nN; G = G_; c = c_; }
    __host__ __device__ bool next(int i, Unit& u) const {
        const long L = (long)i * G + c; if (L >= nwg) return false;
        int wgid = (int)L; { const int q = nwg / NXCD, r = nwg % NXCD, xcd = wgid % NXCD, off = wgid / NXCD; wgid = (xcd < r ? xcd * (q + 1) : r * (q + 1) + (xcd - r) * q) + off; }
        const int nig = WGM * nN, gid = wgid / nig, fm = gid * WGM, gsz = (nM - fm) < WGM ? (nM - fm) : WGM;
        u.pm = fm + ((wgid % nig) % gsz); u.pn = (wgid % nig) / gsz; return true;
    }
    __device__ __forceinline__ void a_ready(const Unit&) const {}
    __device__ __forceinline__ void done(const Unit&) const {}
};

__device__ __forceinline__ unsigned cvt_pk_bf16(float lo, float hi) { unsigned r; asm volatile("v_cvt_pk_bf16_f32 %0, %1, %2" : "=v"(r) : "v"(lo), "v"(hi)); return r; }
template <class Epi, class Sched, bool ALIGN_EPI = false, bool SP2 = false>
__device__ __forceinline__ void gemm_phase(PG8_LAS unsigned char* lds, const Gemm g, const Sched& S, const Epi& E) {
    const int tid = threadIdx.x, wid = __builtin_amdgcn_readfirstlane(tid >> 6), lane = tid & 63, wr = wid >> 2, wc = wid & 3, fr = lane & 15, fq = lane >> 4;
    const int K = g.K, nt = K / BK;
    unsigned voffA[2], voffB[2];
#pragma unroll
    for (int i = 0; i < 2; ++i) { int R, C; stage_rc(tid * 16 + i * 8192, R, C); const int Rb = Epi::PERM ? ((R & ~31) + perm32(R & 31)) : R;
        voffA[i] = (unsigned)(R * K + C) * 2u; voffB[i] = (unsigned)(Rb * K + C) * 2u; }
    const size_t kstep = (size_t)(BK * 2);
    const size_t hstep = (size_t)HALF * K * 2;
    const size_t tstep = 2 * hstep;
    const unsigned ldsw = (unsigned)wid * 1024u;
    const int aoff = lds_byte(wr * 64 + fr, fq * 8), boff = lds_byte(wc * 32 + fr, fq * 8);
#define PG8_SA(b, h) (((b) * 2 + (h)) * HTB)
#define PG8_SB(b, h) ((4 + (b) * 2 + (h)) * HTB)
#define PG8_STAGE(bufoff, gbase, voff) do { _Pragma("unroll") for (int _i = 0; _i < 2; ++_i) \
        __builtin_amdgcn_global_load_lds((const unsigned*)((const char*)(gbase) + (voff)[_i]), (PG8_LAS unsigned*)(lds + (bufoff) + ldsw + _i * 8192), 16, 0, 0); } while (0)
#define PG8_LDA(dst, b, h) do { _Pragma("unroll") for (int m = 0; m < 4; ++m) _Pragma("unroll") for (int k = 0; k < 2; ++k) dst[m][k] = *(const PG8_LAS bf16x8*)(lds + PG8_SA(b, h) + aoff + m * 2048 + k * 1024); } while (0)
#define PG8_LDB(dst, b, h) do { _Pragma("unroll") for (int n = 0; n < 2; ++n) _Pragma("unroll") for (int k = 0; k < 2; ++k) dst[n][k] = *(const PG8_LAS bf16x8*)(lds + PG8_SB(b, h) + boff + n * 2048 + k * 1024); } while (0)
#define PG8_MMA(ai, bj, At, Bt) do { __builtin_amdgcn_s_setprio(1); _Pragma("unroll") for (int m = 0; m < 4; ++m) _Pragma("unroll") for (int n = 0; n < 2; ++n) _Pragma("unroll") for (int k = 0; k < 2; ++k) \
        acc[ai][bj][m][n] = __builtin_amdgcn_mfma_f32_16x16x32_bf16(Bt[n][k], At[m][k], acc[ai][bj][m][n], 0, 0, 0); __builtin_amdgcn_s_setprio(0); } while (0)
#define PG8_WAIT_V(n) asm volatile("s_waitcnt vmcnt(" #n ")" ::: "memory")
#define PG8_WAIT_L(n) asm volatile("s_waitcnt lgkmcnt(" #n ")" ::: "memory")
#define PG8_BAR __builtin_amdgcn_s_barrier()
#define PG8_SCHED __builtin_amdgcn_sched_barrier(0)
    Unit cur, nxt; int ui = 0;
    if (!S.next(0, cur)) return;
    f32x4 acc[2][2][4][2];
#pragma unroll
    for (int a = 0; a < 2; ++a)
#pragma unroll
        for (int b = 0; b < 2; ++b)
#pragma unroll
            for (int m = 0; m < 4; ++m)
#pragma unroll
                for (int n = 0; n < 2; ++n) acc[a][b][m][n] = (f32x4){0.f, 0.f, 0.f, 0.f};
    bf16x8 At[4][2], B0[2][2], B1[2][2];
    const char* cA = (const char*)g.A + (size_t)cur.pm * tstep; const char* cB = (const char*)g.Bt + (size_t)cur.pn * tstep;
    S.a_ready(cur);
    if constexpr (SP2) {
        PG8_STAGE(PG8_SB(0, 0), cB, voffB); PG8_STAGE(PG8_SB(0, 1), cB + hstep, voffB); PG8_STAGE(PG8_SA(0, 0), cA, voffA); PG8_STAGE(PG8_SA(0, 1), cA + hstep, voffA);
        if (wr == 1) PG8_BAR;
        PG8_WAIT_V(2); PG8_BAR;
        PG8_STAGE(PG8_SB(1, 0), cB + kstep, voffB); PG8_STAGE(PG8_SA(1, 0), cA + kstep, voffA); PG8_STAGE(PG8_SB(1, 1), cB + hstep + kstep, voffB);
        PG8_WAIT_V(6); PG8_BAR;
    } else {
        PG8_STAGE(PG8_SB(0, 0), cB, voffB); PG8_STAGE(PG8_SA(0, 0), cA, voffA); PG8_STAGE(PG8_SB(0, 1), cB + hstep, voffB); PG8_STAGE(PG8_SA(0, 1), cA + hstep, voffA);
        if (wr == 1) PG8_BAR;
        PG8_WAIT_V(4); PG8_BAR;
        PG8_STAGE(PG8_SB(1, 0), cB + kstep, voffB); PG8_STAGE(PG8_SA(1, 0), cA + kstep, voffA); PG8_STAGE(PG8_SB(1, 1), cB + hstep + kstep, voffB);
        PG8_WAIT_V(6); PG8_BAR;
    }
    for (;;) {
        const bool has_next = S.next(ui + 1, nxt);
        const char* nA = has_next ? (const char*)g.A + (size_t)nxt.pm * tstep : cA; const char* nB = has_next ? (const char*)g.Bt + (size_t)nxt.pn * tstep : cB;
        for (int t = 0; t < nt; t += 2) {
            const bool last = (t == nt - 2);
            const char* a1 = cA + (size_t)(t + 1) * kstep;
            const char* a2 = last ? nA : cA + (size_t)(t + 2) * kstep; const char* b2 = last ? nB : cB + (size_t)(t + 2) * kstep;
            const char* a3 = a2 + kstep; const char* b3 = b2 + kstep;
            if (last && has_next) S.a_ready(nxt);
            if constexpr (SP2) {
            PG8_LDB(B0, 0, 0); PG8_LDB(B1, 0, 1); PG8_SCHED; PG8_LDA(At, 0, 0); PG8_STAGE(PG8_SA(1, 1), a1 + hstep, voffA);
            PG8_WAIT_V(8); PG8_WAIT_L(0); PG8_BAR; PG8_MMA(0, 0, At, B0); PG8_MMA(0, 1, At, B1); PG8_BAR; PG8_SCHED;
            PG8_LDA(At, 0, 1); PG8_STAGE(PG8_SB(0, 0), b2, voffB); PG8_STAGE(PG8_SB(0, 1), b2 + hstep, voffB); PG8_STAGE(PG8_SA(0, 0), a2, voffA);
            PG8_WAIT_V(8); PG8_WAIT_L(0); PG8_BAR; PG8_MMA(1, 0, At, B0); PG8_MMA(1, 1, At, B1); PG8_BAR; PG8_SCHED;
            PG8_LDB(B0, 1, 0); PG8_LDB(B1, 1, 1); PG8_SCHED; PG8_LDA(At, 1, 0); PG8_STAGE(PG8_SA(0, 1), a2 + hstep, voffA);
            PG8_WAIT_V(8); PG8_WAIT_L(0); PG8_BAR; PG8_MMA(0, 0, At, B0); PG8_MMA(0, 1, At, B1); PG8_BAR; PG8_SCHED;
            PG8_LDA(At, 1, 1); PG8_STAGE(PG8_SB(1, 0), b3, voffB); PG8_STAGE(PG8_SB(1, 1), b3 + hstep, voffB); PG8_STAGE(PG8_SA(1, 0), a3, voffA);
            PG8_WAIT_V(8); PG8_WAIT_L(0); PG8_BAR; PG8_MMA(1, 0, At, B0); PG8_MMA(1, 1, At, B1); PG8_BAR; PG8_SCHED;
            } else {
            PG8_LDB(B0, 0, 0); PG8_SCHED; PG8_LDA(At, 0, 0); PG8_STAGE(PG8_SA(1, 1), a1 + hstep, voffA);
            PG8_WAIT_L(8); PG8_BAR; PG8_WAIT_L(0); PG8_MMA(0, 0, At, B0); PG8_BAR; PG8_SCHED;
            PG8_LDB(B1, 0, 1); PG8_STAGE(PG8_SB(0, 0), b2, voffB);
            PG8_BAR; PG8_WAIT_L(0); PG8_MMA(0, 1, At, B1); PG8_BAR;
            PG8_LDA(At, 0, 1); PG8_STAGE(PG8_SA(0, 0), a2, voffA);
            PG8_BAR; PG8_WAIT_L(0); PG8_MMA(1, 0, At, B0); PG8_BAR; PG8_SCHED;
            PG8_STAGE(PG8_SB(0, 1), b2 + hstep, voffB);
            PG8_WAIT_V(6); PG8_BAR; PG8_MMA(1, 1, At, B1); PG8_BAR;
            PG8_LDB(B0, 1, 0); PG8_SCHED; PG8_LDA(At, 1, 0); PG8_STAGE(PG8_SA(0, 1), a2 + hstep, voffA);
            PG8_WAIT_L(8); PG8_BAR; PG8_WAIT_L(0); PG8_MMA(0, 0, At, B0); PG8_BAR; PG8_SCHED;
            PG8_LDB(B1, 1, 1); PG8_STAGE(PG8_SB(1, 0), b3, voffB);
            PG8_BAR; PG8_WAIT_L(0); PG8_MMA(0, 1, At, B1); PG8_BAR;
            PG8_LDA(At, 1, 1); PG8_STAGE(PG8_SA(1, 0), a3, voffA);
            PG8_BAR; PG8_WAIT_L(0); PG8_MMA(1, 0, At, B0); PG8_BAR; PG8_SCHED;
            PG8_STAGE(PG8_SB(1, 1), b3 + hstep, voffB);
            PG8_WAIT_V(6); PG8_BAR; PG8_MMA(1, 1, At, B1); PG8_BAR;
            }
        }
        if constexpr (ALIGN_EPI) { if (wr == 0) PG8_BAR; }
        if constexpr (!Epi::AFTER_DRAIN) { E(acc, cur, wr, wc, fr, fq); S.done(cur); }
        if (!has_next) break;
#pragma unroll
        for (int a = 0; a < 2; ++a)
#pragma unroll
            for (int b = 0; b < 2; ++b)
#pragma unroll
                for (int m = 0; m < 4; ++m)
#pragma unroll
                    for (int n = 0; n < 2; ++n) acc[a][b][m][n] = (f32x4){0.f, 0.f, 0.f, 0.f};
        cur = nxt; cA = nA; cB = nB; ++ui;
        if constexpr (ALIGN_EPI) { if (wr == 1) PG8_BAR; }
    }
    PG8_WAIT_V(0);
    if constexpr (!ALIGN_EPI) { if (wr == 0) PG8_BAR; }
    PG8_BAR;
    if constexpr (Epi::AFTER_DRAIN) { E.fused(acc, cur, wr, wc, fr, fq, lds, wid, lane); S.done(cur); }
#undef PG8_SA
#undef PG8_SB
#undef PG8_STAGE
#undef PG8_LDA
#undef PG8_LDB
#undef PG8_MMA
#undef PG8_WAIT_V
#undef PG8_WAIT_L
#undef PG8_BAR
#undef PG8_SCHED
}
}

#define LAS __attribute__((address_space(3)))
typedef unsigned short bf16;
typedef unsigned v4u __attribute__((ext_vector_type(4)));
typedef unsigned v2u __attribute__((ext_vector_type(2)));
typedef float f32x4 __attribute__((ext_vector_type(4)));
typedef short bf16x8 __attribute__((ext_vector_type(8)));
constexpr int DM = 2048, MTOT = 40960, MPROMPT = 8192, DIN = 4896, DINP = 5120, PLD = 4928  , NCHUNKS = 320;
constexpr int C_ZSSD = 1536, C_DT = 2560, C_Q = 2592, C_K = 3104, C_V = 3232, C_ZATT = 3360, C_MQ = 3872, C_ZMEM = 4384;
constexpr float EPS = 1e-6f;
constexpr size_t MiB = 1u << 20;
constexpr size_t WS_WIN = 2 * MiB, WS_WOUT = 22 * MiB, WS_WMEM = 30 * MiB, WS_MEMN = 34 * MiB, WS_MKV = 42 * MiB, WS_DT = 46 * MiB, WS_CD = 51 * MiB,
                 WS_BN = 52 * MiB, WS_CN = 72 * MiB, WS_XT = 92 * MiB, WS_ST = 172 * MiB, WS_CC = 332 * MiB, WS_PROJ = 492 * MiB, WS_END = 878 * MiB;
constexpr size_t OUT_XN = 0, OUT_SP = 160 * MiB;
constexpr size_t WS_BAR = 65536, WS_CTL_BYTES = 131072;
constexpr int LDS_BYTES = 147456;
#ifndef EXPT
#define EXPT 0
#endif
#ifndef DUPMASK
#define DUPMASK 0
#endif
#ifndef GEMM_ALIGN
#define GEMM_ALIGN true
#endif

struct Params {
    const float *x_prompt, *x_sample, *mem_prompt, *mem_sample, *norm_g, *w_in, *conv_w, *conv_b, *dt_bias, *a_log, *d_skip, *ssd_norm_g, *q_norm_g, *k_norm_g, *sink,
                *mem_norm_g, *w_mem_kv, *mq_norm_g, *mk_norm_g, *w_out;
    float* out; unsigned char* ws;
};

__device__ __forceinline__ float bf_lo(unsigned u) { return __uint_as_float(u << 16); }
__device__ __forceinline__ float bf_hi(unsigned u) { return __uint_as_float(u & 0xffff0000u); }
__device__ __forceinline__ float bf1(bf16 v) { return __uint_as_float((unsigned)v << 16); }
typedef float f32x2_t __attribute__((ext_vector_type(2))); typedef __bf16 bf16x2_t __attribute__((ext_vector_type(2)));
__device__ __forceinline__ unsigned pk2(float lo, float hi) { f32x2_t v = {lo, hi}; bf16x2_t b = __builtin_convertvector(v, bf16x2_t); return __builtin_bit_cast(unsigned, b); }
__device__ __forceinline__ bf16 f2bf(float f) { return (bf16)(pk2(f, 0.f) & 0xffffu); }
__device__ __forceinline__ float silu(float v) { return v / (1.f + __expf(-v)); }
__device__ __forceinline__ float softplus(float v) { return fmaxf(v, 0.f) + log1pf(__expf(-fabsf(v))); }
__device__ __forceinline__ void unpack8(v4u r, float* f) { f[0] = bf_lo(r.x); f[1] = bf_hi(r.x); f[2] = bf_lo(r.y); f[3] = bf_hi(r.y); f[4] = bf_lo(r.z); f[5] = bf_hi(r.z); f[6] = bf_lo(r.w); f[7] = bf_hi(r.w); }
__device__ __forceinline__ v4u pack8(const float* f) { v4u r; r.x = pk2(f[0], f[1]); r.y = pk2(f[2], f[3]); r.z = pk2(f[4], f[5]); r.w = pk2(f[6], f[7]); return r; }
__device__ __forceinline__ bf16x8 as_frag(v4u r) { return __builtin_bit_cast(bf16x8, r); }
__device__ __forceinline__ f32x4 mfma16(bf16x8 a, bf16x8 b, f32x4 c) { return __builtin_amdgcn_mfma_f32_16x16x32_bf16(a, b, c, 0, 0, 0); }
__device__ __forceinline__ float wave_sum(float v) {
#pragma unroll
    for (int o = 1; o < 64; o <<= 1) v += __shfl_xor(v, o);
    return v;
}
__device__ __forceinline__ float wave_incl_scan(float v, int lane, LAS float* sc, float& tot) {
    sc[lane] = v; asm volatile("s_waitcnt lgkmcnt(0)" ::: "memory");
    float s = 0.f, t = 0.f;
#pragma unroll 8
    for (int k = 0; k < 64; ++k) { const float x = sc[k]; t += x; s += (k <= lane) ? x : 0.f; }
    asm volatile("s_waitcnt lgkmcnt(0)" ::: "memory");
    tot = t; return s;
}
__device__ __forceinline__ void chunk_info(int cgi, int& T, int& t0, int& bg) {
    if (cgi < 64) { T = 2048; t0 = (cgi & 15) * 128; bg = cgi >> 4; } else { const int q = cgi - 64; T = 8192; t0 = (q & 63) * 128; bg = 4 + (q >> 6); }
}
__device__ __forceinline__ int prow(int r) { return r + (r >> 3); }

__device__ __forceinline__ void p0_transpose_item(const float* W, int K, int N, bf16* WT, LAS float* scr, int item, int lane) {
    const int nblk = N / 32, kb = item / nblk, nb = item % nblk, k0 = 64 * kb, n0 = 32 * nb;
    float tv[32];
#pragma unroll
    for (int i = 0; i < 32; ++i) tv[i] = W[(size_t)(k0 + 2 * i + (lane >> 5)) * N + n0 + (lane & 31)];
#pragma unroll
    for (int i = 0; i < 32; ++i) scr[(2 * i + (lane >> 5)) * 33 + (lane & 31)] = tv[i];
    asm volatile("s_waitcnt lgkmcnt(0)" ::: "memory");
    const int c = lane & 7;
#pragma unroll
    for (int j = 0; j < 4; ++j) { const int n = (lane >> 3) + 8 * j; const LAS float* s = scr + (8 * c) * 33 + n;
        v4u o; o.x = pk2(s[0 * 33], s[1 * 33]); o.y = pk2(s[2 * 33], s[3 * 33]); o.z = pk2(s[4 * 33], s[5 * 33]); o.w = pk2(s[6 * 33], s[7 * 33]);
        *(v4u*)(WT + (size_t)(n0 + n) * K + k0 + 8 * c) = o; }
    asm volatile("s_waitcnt lgkmcnt(0)" ::: "memory");
}
template <int NR> __device__ __forceinline__ void rms_rows_to_bf16(const float* const (&xrow)[NR], const float* g, bf16* const (&orow)[NR], int lane) {
    f32x4 v[NR][8];
#pragma unroll
    for (int r = 0; r < NR; ++r) { const f32x4* xr = (const f32x4*)xrow[r] + lane;
#pragma unroll
        for (int j = 0; j < 8; ++j) v[r][j] = __builtin_nontemporal_load(xr + 64 * j); }
    const f32x4* gr = (const f32x4*)g + lane;
#pragma unroll
    for (int r = 0; r < NR; ++r) { float s = 0.f;
#pragma unroll
        for (int j = 0; j < 8; ++j) s += (v[r][j].x * v[r][j].x + v[r][j].y * v[r][j].y) + (v[r][j].z * v[r][j].z + v[r][j].w * v[r][j].w);
        const float rstd = rsqrtf(wave_sum(s) * (1.f / DM) + EPS);
        v2u* o8 = (v2u*)orow[r] + lane;
#pragma unroll
        for (int j = 0; j < 8; ++j) { const f32x4 gg = gr[64 * j]; v2u o; o.x = pk2(v[r][j].x * rstd * gg.x, v[r][j].y * rstd * gg.y); o.y = pk2(v[r][j].z * rstd * gg.z, v[r][j].w * rstd * gg.w); __builtin_nontemporal_store(o, o8 + 64 * j); } }
}
__device__ __forceinline__ void p0_prologue(LAS unsigned char* lds, const Params& P) {
    const int tid = threadIdx.x, lane = tid & 63, wave = tid >> 6;
    LAS float* scr = (LAS float*)(lds + wave * 16384);
    const int gw = blockIdx.x * 8 + wave, NGW = gridDim.x * 8;
    bf16* WinT = (bf16*)(P.ws + WS_WIN); bf16* WoutT = (bf16*)(P.ws + WS_WOUT); bf16* WmemT = (bf16*)(P.ws + WS_WMEM);
    constexpr int I_IN = 32 * (DIN / 32), I_OUT = 32 * (DM / 32), I_MEM = 32 * (1024 / 32);
    for (int it = gw; it < I_IN + I_OUT + I_MEM; it += NGW) {
        int r = it;
        if (r < I_IN) { p0_transpose_item(P.w_in, DM, DIN, WinT, scr, r, lane); continue; } r -= I_IN;
        if (r < I_OUT) { p0_transpose_item(P.w_out, DM, DM, WoutT, scr, r, lane); continue; } r -= I_OUT;
        p0_transpose_item(P.w_mem_kv, DM, 1024, WmemT, scr, r, lane);
    }
    { v4u* z = (v4u*)(WinT + (size_t)DIN * DM); const int nz = (DINP - DIN) * DM / 8; const v4u zero = {0u, 0u, 0u, 0u};
      for (int i = blockIdx.x * 512 + tid; i < nz; i += gridDim.x * 512) z[i] = zero; }
    bf16* XN = (bf16*)((unsigned char*)P.out + OUT_XN); bf16* MEMN = (bf16*)(P.ws + WS_MEMN);
    for (int m4 = gw; m4 < (MTOT + 2048) / 4; m4 += NGW) {
        const int m = m4 * 4; const float* src; const float* gain; bf16* dst;
        if (m < MPROMPT) { src = P.x_prompt + (size_t)m * DM; gain = P.norm_g; dst = XN + (size_t)m * DM; }
        else if (m < MTOT) { src = P.x_sample + (size_t)(m - MPROMPT) * DM; gain = P.norm_g; dst = XN + (size_t)m * DM; }
        else { const int r = m - MTOT; src = r < 1024 ? P.mem_prompt + (size_t)r * DM : P.mem_sample + (size_t)(r - 1024) * DM; gain = P.mem_norm_g; dst = MEMN + (size_t)r * DM; }
        const float* const xr[4] = {src, src + DM, src + 2 * DM, src + 3 * DM}; bf16* const orr[4] = {dst, dst + DM, dst + 2 * DM, dst + 3 * DM};
        rms_rows_to_bf16<4>(xr, gain, orr, lane);
    }
}

struct EpiProj {
    static constexpr bool PERM = true, AFTER_DRAIN = false;
    bf16* O; float* DT;
    __device__ __forceinline__ void operator()(const pg8::f32x4 (&acc)[2][2][4][2], const pg8::Unit& u, int wr, int wc, int fr, int fq) const {
        const int row0 = u.pm * 256 + wr * 64 + fr, col0 = u.pn * 256 + wc * 32 + 8 * fq;
#pragma unroll
        for (int ai = 0; ai < 2; ++ai)
#pragma unroll
            for (int m = 0; m < 4; ++m) { const size_t row = (size_t)(row0 + ai * 128 + m * 16);
#pragma unroll
                for (int bj = 0; bj < 2; ++bj) { const int col = col0 + bj * 128; if (col >= DIN) continue;
                    const pg8::f32x4 v0 = acc[ai][bj][m][0], v1 = acc[ai][bj][m][1];
                    v4u w; w.x = pk2(v0[0], v0[1]); w.y = pk2(v0[2], v0[3]); w.z = pk2(v1[0], v1[1]); w.w = pk2(v1[2], v1[3]);
                    *(v4u*)(O + row * PLD + col) = w;
                    if (col >= C_DT && col < C_DT + 32) { float* d = DT + row * 32 + (col - C_DT); *(f32x4*)d = v0; *(f32x4*)(d + 4) = v1; } } }
    }
};
struct EpiPlain {
    static constexpr bool PERM = true, AFTER_DRAIN = false;
    bf16* O; int ldc;
    __device__ __forceinline__ void operator()(const pg8::f32x4 (&acc)[2][2][4][2], const pg8::Unit& u, int wr, int wc, int fr, int fq) const {
        const int row0 = u.pm * 256 + wr * 64 + fr, col0 = u.pn * 256 + wc * 32 + 8 * fq;
#pragma unroll
        for (int ai = 0; ai < 2; ++ai)
#pragma unroll
            for (int m = 0; m < 4; ++m) { const size_t row = (size_t)(row0 + ai * 128 + m * 16);
#pragma unroll
                for (int bj = 0; bj < 2; ++bj) { const int col = col0 + bj * 128;
                    const pg8::f32x4 v0 = acc[ai][bj][m][0], v1 = acc[ai][bj][m][1];
                    v4u w; w.x = pk2(v0[0], v0[1]); w.y = pk2(v0[2], v0[3]); w.z = pk2(v1[0], v1[1]); w.w = pk2(v1[2], v1[3]);
                    *(v4u*)(O + row * ldc + col) = w; } }
    }
};
struct EpiOut {
    static constexpr bool PERM = false, AFTER_DRAIN = false;
    const float* xp; const float* xs; float* out;
    __device__ __forceinline__ void operator()(const pg8::f32x4 (&acc)[2][2][4][2], const pg8::Unit& u, int wr, int wc, int fr, int fq) const {
        const int row0 = u.pm * 256 + wr * 64 + fr, col0 = u.pn * 256 + wc * 32 + 4 * fq;
        const float* xb = (u.pm < MPROMPT / 256) ? xp : xs - (size_t)MPROMPT * DM;
#pragma unroll
        for (int ai = 0; ai < 2; ++ai)
#pragma unroll
            for (int m = 0; m < 4; ++m) { const size_t off = (size_t)(row0 + ai * 128 + m * 16) * DM + col0;
#pragma unroll
                for (int bj = 0; bj < 2; ++bj)
#pragma unroll
                    for (int n = 0; n < 2; ++n) { const pg8::f32x4 xv = *(const pg8::f32x4*)(xb + off + bj * 128 + n * 16); *(pg8::f32x4*)(out + off + bj * 128 + n * 16) = xv + acc[ai][bj][m][n]; } }
    }
};
struct MemOrder {
    int c, G;
    __device__ bool next(int i, pg8::Unit& u) const { const int cc = (c + G - (128 % G)) % G; const int k = i * G + cc; if (k >= 32) return false; u.pm = k >> 2; u.pn = k & 3; return true; }
    __device__ __forceinline__ void a_ready(const pg8::Unit&) const {}
    __device__ __forceinline__ void done(const pg8::Unit&) const {}
};

__device__ __forceinline__ void conv_run4(const bf16* PROJ, const float* cw, const float* cb, int m0, int t0, int T, int j0, int ch0, bool to_img, LAS bf16* img, int row0, bf16* nat) {
    unsigned xr[8][4];
#pragma unroll
    for (int r = 0; r < 8; ++r) { const int t = t0 + j0 - 2 + r; v4u raw = {0u, 0u, 0u, 0u}; if (t >= 0 && t < T) raw = *(const v4u*)(PROJ + (size_t)(m0 + j0 - 2 + r) * PLD + ch0);
        xr[r][0] = raw.x; xr[r][1] = raw.y; xr[r][2] = raw.z; xr[r][3] = raw.w; }
    unsigned res[4][4];
    float wt[5][8], bs[8];
#pragma unroll
    for (int k = 0; k < 5; ++k) { const f32x4 w0 = *(const f32x4*)(cw + k * 1536 + ch0), w1 = *(const f32x4*)(cw + k * 1536 + ch0 + 4);
        wt[k][0] = w0.x; wt[k][1] = w0.y; wt[k][2] = w0.z; wt[k][3] = w0.w; wt[k][4] = w1.x; wt[k][5] = w1.y; wt[k][6] = w1.z; wt[k][7] = w1.w; }
    { const f32x4 b0 = *(const f32x4*)(cb + ch0), b1 = *(const f32x4*)(cb + ch0 + 4); bs[0] = b0.x; bs[1] = b0.y; bs[2] = b0.z; bs[3] = b0.w; bs[4] = b1.x; bs[5] = b1.y; bs[6] = b1.z; bs[7] = b1.w; }
#pragma unroll
    for (int cp = 0; cp < 4; ++cp) {
        float wl[5], wh[5];
#pragma unroll
        for (int k = 0; k < 5; ++k) { wl[k] = wt[k][2 * cp]; wh[k] = wt[k][2 * cp + 1]; }
        const float bl = bs[2 * cp], bh = bs[2 * cp + 1];
        float al[4], ah[4];
#pragma unroll
        for (int tk = 0; tk < 4; ++tk) { al[tk] = bl; ah[tk] = bh; }
#pragma unroll
        for (int r = 0; r < 8; ++r) { const float xl = bf_lo(xr[r][cp]), xh = bf_hi(xr[r][cp]);
#pragma unroll
            for (int k = 0; k < 5; ++k) { const int tk = r - k; if (tk >= 0 && tk < 4) { al[tk] += wl[k] * xl; ah[tk] += wh[k] * xh; } } }
#pragma unroll
        for (int tk = 0; tk < 4; ++tk) { al[tk] = silu(al[tk]); ah[tk] = silu(ah[tk]); res[tk][cp] = pk2(al[tk], ah[tk]); }
        if (to_img) {
            v2u o; o.x = pk2(al[0], al[1]); o.y = pk2(al[2], al[3]); *(LAS v2u*)(img + prow(row0 + 2 * cp) * 136 + j0) = o;
            o.x = pk2(ah[0], ah[1]); o.y = pk2(ah[2], ah[3]); *(LAS v2u*)(img + prow(row0 + 2 * cp + 1) * 136 + j0) = o;
        }
        __builtin_amdgcn_sched_barrier(0);
    }
    if (nat) {
#pragma unroll
        for (int tk = 0; tk < 4; ++tk) { v4u o; o.x = res[tk][0]; o.y = res[tk][1]; o.z = res[tk][2]; o.w = res[tk][3]; *(v4u*)(nat + tk * 256) = o; }
    }
}
constexpr int TS = 136;
__device__ __forceinline__ void ssd_state_item(LAS unsigned char* lds, const Params& P, int item) {
    const int tid = threadIdx.x, lane = tid & 63, w = tid >> 6, fr = lane & 15, fq = lane >> 4;
    const int cgi = item >> 2, g = (item >> 1) & 1, hq = item & 1;
    int T, t0, bg; chunk_info(cgi, T, t0, bg);
    const int m0 = cgi * 128;
    const bf16* PROJ = (const bf16*)(P.ws + WS_PROJ); const float* DT = (const float*)(P.ws + WS_DT); float* CD = (float*)(P.ws + WS_CD);
    bf16* BN = (bf16*)(P.ws + WS_BN); bf16* CN = (bf16*)(P.ws + WS_CN); bf16* XTg = (bf16*)(P.ws + WS_XT); bf16* ST = (bf16*)(P.ws + WS_ST);
    LAS bf16* XT = (LAS bf16*)lds;
    LAS bf16* BT = XT + 288 * TS;
    LAS float* WF = (LAS float*)(BT + 144 * TS);
    {
        const int dir = w >> 2, hh = w & 3, head = g * 8 + hq * 4 + hh;
        const float bias = P.dt_bias[dir * 16 + head], A = -__expf(P.a_log[dir * 16 + head]);
        const float r0 = DT[(size_t)(m0 + 2 * lane) * 32 + dir * 16 + head], r1 = DT[(size_t)(m0 + 2 * lane + 1) * 32 + dir * 16 + head];
        const float d0 = softplus(r0 + bias), d1 = softplus(r1 + bias), a0 = d0 * A, a1 = d1 * A;
        float tot; const float inc = wave_incl_scan(a0 + a1, lane, WF + 1024 + w * 64, tot);
        const float p1 = inc, p0 = inc - a1;
        float w0, w1;
        if (dir == 0) { w0 = d0 * __expf(tot - p0); w1 = d1 * __expf(tot - p1); }
        else { w0 = d0 * __expf(p0 - a0); w1 = d1 * __expf(p1 - a1); }
        WF[(dir * 4 + hh) * 128 + 2 * lane] = w0; WF[(dir * 4 + hh) * 128 + 2 * lane + 1] = w1;
        if (lane == 0) CD[item * 32 + dir * 4 + hh] = __expf(tot);
    }
#pragma unroll 1
    for (int rnd = 0; rnd < 3 + hq; ++rnd) {
        const bool isx = rnd < 2;
        const int c8 = isx ? (tid & 31) : (tid & 15), j0 = (isx ? (tid >> 5) + 16 * rnd : (tid >> 4)) * 4;
        const int ch0 = isx ? g * 512 + hq * 256 + c8 * 8 : 1024 + (rnd - 2) * 256 + g * 128 + c8 * 8;
        LAS bf16* img = isx ? XT : BT;
        bf16* nat = isx ? (bf16*)nullptr : (rnd == 2 ? (hq == 0 ? BN + (size_t)(m0 + j0) * 256 + g * 128 + c8 * 8 : (bf16*)nullptr) : CN + (size_t)(m0 + j0) * 256 + g * 128 + c8 * 8);
        conv_run4(PROJ, P.conv_w, P.conv_b, m0, t0, T, j0, ch0, rnd < 3, img, c8 * 8, nat);
    }
    __syncthreads();
    for (int q = tid; q < 4096; q += 512) { const int j8 = q & 15, r = q >> 4;
        *(v4u*)(XTg + ((size_t)cgi * 1024 + g * 512 + hq * 256 + r) * 128 + j8 * 8) = *(const LAS v4u*)(XT + prow(r) * TS + j8 * 8); }
    const int hh = w >> 1, dir = w & 1, head = g * 8 + hq * 4 + hh;
    bf16* sp = ST + ((size_t)(cgi * 2 + dir) * 16 + head) * 8192;
#pragma unroll 1
    for (int nh = 0; nh < 2; ++nh) {
        f32x4 acc[4][4];
#pragma unroll
        for (int a = 0; a < 4; ++a)
#pragma unroll
            for (int b = 0; b < 4; ++b) acc[a][b] = (f32x4){0.f, 0.f, 0.f, 0.f};
#pragma unroll 1
        for (int ks = 0; ks < 4; ++ks) {
            const int jb = ks * 32 + 8 * fq;
            bf16x8 bfr[4];
#pragma unroll
            for (int nt = 0; nt < 4; ++nt) bfr[nt] = as_frag(*(const LAS v4u*)(BT + prow(nh * 64 + nt * 16 + fr) * TS + jb));
            float wv[8];
            { const f32x4 a = *(const LAS f32x4*)(WF + (dir * 4 + hh) * 128 + jb), b = *(const LAS f32x4*)(WF + (dir * 4 + hh) * 128 + jb + 4);
              wv[0] = a.x; wv[1] = a.y; wv[2] = a.z; wv[3] = a.w; wv[4] = b.x; wv[5] = b.y; wv[6] = b.z; wv[7] = b.w; }
#pragma unroll
            for (int pt = 0; pt < 4; ++pt) {
                float xv[8]; unpack8(*(const LAS v4u*)(XT + prow(hh * 64 + pt * 16 + fr) * TS + jb), xv);
#pragma unroll
                for (int e = 0; e < 8; ++e) xv[e] *= wv[e];
                const bf16x8 af = as_frag(pack8(xv));
#pragma unroll
                for (int nt = 0; nt < 4; ++nt) acc[pt][nt] = mfma16(bfr[nt], af, acc[pt][nt]);
            }
        }
#pragma unroll
        for (int pt = 0; pt < 4; ++pt)
#pragma unroll
            for (int nt = 0; nt < 4; ++nt) { v2u o; o.x = pk2(acc[pt][nt][0], acc[pt][nt][1]); o.y = pk2(acc[pt][nt][2], acc[pt][nt][3]);
                *(v2u*)(sp + (pt * 16 + fr) * 128 + nh * 64 + nt * 16 + 4 * fq) = o; }
    }
    __syncthreads();
}

__device__ __forceinline__ void transpose8x8_bf16(const v4u (&in)[8], v4u (&out)[8]) {
#pragma unroll
    for (int c2 = 0; c2 < 4; ++c2) {
        unsigned r[8];
#pragma unroll
        for (int k = 0; k < 8; ++k) r[k] = c2 == 0 ? in[k].x : (c2 == 1 ? in[k].y : (c2 == 2 ? in[k].z : in[k].w));
        v4u lo, hi;
        lo.x = __builtin_amdgcn_perm(r[1], r[0], 0x05040100u); lo.y = __builtin_amdgcn_perm(r[3], r[2], 0x05040100u); lo.z = __builtin_amdgcn_perm(r[5], r[4], 0x05040100u); lo.w = __builtin_amdgcn_perm(r[7], r[6], 0x05040100u);
        hi.x = __builtin_amdgcn_perm(r[1], r[0], 0x07060302u); hi.y = __builtin_amdgcn_perm(r[3], r[2], 0x07060302u); hi.z = __builtin_amdgcn_perm(r[5], r[4], 0x07060302u); hi.w = __builtin_amdgcn_perm(r[7], r[6], 0x07060302u);
        out[2 * c2] = lo; out[2 * c2 + 1] = hi;
    }
}
constexpr int WK_ROWS = 416, WK_S = 72, WV_S = 424;
__device__ __forceinline__ void win_attn_item(LAS unsigned char* lds, const Params& P, int item) {
    const int tid = threadIdx.x, lane = tid & 63, w = tid >> 6, fr = lane & 15, fq = lane >> 4;
    const int cgi = item >> 1, kvh = item & 1;
    int T, t0, bg; chunk_info(cgi, T, t0, bg);
    const int m0 = cgi * 128;
    const bf16* PROJ = (const bf16*)(P.ws + WS_PROJ); bf16* CC = (bf16*)(P.ws + WS_CC);
    LAS bf16* Ks = (LAS bf16*)lds;
    LAS bf16* VT = Ks + WK_ROWS * WK_S;
    if (tid < 416) {
        const int ch = tid & 7, j0 = (tid >> 3) * 8;
        const f32x4 g0 = *(const f32x4*)(P.k_norm_g + ch * 8), g1 = *(const f32x4*)(P.k_norm_g + ch * 8 + 4);
        v4u kin[8], vin[8], vout[8];
#pragma unroll
        for (int k = 0; k < 8; ++k) { const int jj = j0 + k, t = t0 - 128 + jj; const bool ok = (jj < 384) && (t >= 0) && (t < T);
            kin[k] = (v4u){0u, 0u, 0u, 0u}; vin[k] = (v4u){0u, 0u, 0u, 0u};
            if (ok) { const bf16* rowp = PROJ + (size_t)(m0 - 128 + jj) * PLD; kin[k] = *(const v4u*)(rowp + C_K + kvh * 64 + ch * 8); vin[k] = *(const v4u*)(rowp + C_V + kvh * 64 + ch * 8); } }
        __builtin_amdgcn_sched_barrier(0);
#pragma unroll
        for (int k = 0; k < 8; ++k) { const int jj = j0 + k; float kv[8];
            unpack8(kin[k], kv);
            float ss = 0.f;
#pragma unroll
            for (int e = 0; e < 8; ++e) ss += kv[e] * kv[e];
            ss += __shfl_xor(ss, 1); ss += __shfl_xor(ss, 2); ss += __shfl_xor(ss, 4);
            const float rstd = rsqrtf(ss * (1.f / 64.f) + EPS);
            kv[0] *= rstd * g0.x; kv[1] *= rstd * g0.y; kv[2] *= rstd * g0.z; kv[3] *= rstd * g0.w; kv[4] *= rstd * g1.x; kv[5] *= rstd * g1.y; kv[6] *= rstd * g1.z; kv[7] *= rstd * g1.w;
            *(LAS v4u*)(Ks + jj * WK_S + ch * 8) = pack8(kv); }
        transpose8x8_bf16(vin, vout);
#pragma unroll
        for (int e = 0; e < 8; ++e) *(LAS v4u*)(VT + prow(ch * 8 + e) * WV_S + j0) = vout[e];
    }
    __syncthreads();
    const int hh = w >> 1, half = w & 1, H = kvh * 4 + hh;
    const float slope = exp2f(-(float)(H + 1)), sink = P.sink[H];
    for (int qt = 0; qt < 4; ++qt) {
        const int i0 = half * 64 + qt * 16;
        bf16x8 qf[2];
        { float q0[8], q1[8]; const bf16* qp = PROJ + (size_t)(m0 + i0 + fr) * PLD + C_Q + H * 64 + 8 * fq;
          unpack8(*(const v4u*)qp, q0); unpack8(*(const v4u*)(qp + 32), q1);
          float ss = 0.f;
#pragma unroll
          for (int e = 0; e < 8; ++e) ss += q0[e] * q0[e] + q1[e] * q1[e];
          ss += __shfl_xor(ss, 16); ss += __shfl_xor(ss, 32);
          const float sc = rsqrtf(ss * (1.f / 64.f) + EPS) * 0.125f;
          const f32x4 ga = *(const f32x4*)(P.q_norm_g + 8 * fq), gb = *(const f32x4*)(P.q_norm_g + 8 * fq + 4), gc = *(const f32x4*)(P.q_norm_g + 32 + 8 * fq), gd = *(const f32x4*)(P.q_norm_g + 32 + 8 * fq + 4);
          q0[0] *= sc * ga.x; q0[1] *= sc * ga.y; q0[2] *= sc * ga.z; q0[3] *= sc * ga.w; q0[4] *= sc * gb.x; q0[5] *= sc * gb.y; q0[6] *= sc * gb.z; q0[7] *= sc * gb.w;
          q1[0] *= sc * gc.x; q1[1] *= sc * gc.y; q1[2] *= sc * gc.z; q1[3] *= sc * gc.w; q1[4] *= sc * gd.x; q1[5] *= sc * gd.y; q1[6] *= sc * gd.z; q1[7] *= sc * gd.w;
          qf[0] = as_frag(pack8(q0)); qf[1] = as_frag(pack8(q1)); }
        f32x4 st[18];
#pragma unroll
        for (int kt = 0; kt < 18; ++kt) {
            f32x4 a = {0.f, 0.f, 0.f, 0.f};
#pragma unroll
            for (int ks = 0; ks < 2; ++ks) a = mfma16(as_frag(*(const LAS v4u*)(Ks + (i0 + kt * 16 + fr) * WK_S + ks * 32 + 8 * fq)), qf[ks], a);
            st[kt] = a;
        }
        const int iq = i0 + fr + 128;
        float mx = sink;
#pragma unroll
        for (int kt = 0; kt < 18; ++kt)
#pragma unroll
            for (int r = 0; r < 4; ++r) { const int jj = i0 + kt * 16 + 4 * fq + r, t = t0 - 128 + jj; int dist = iq - jj; dist = dist < 0 ? -dist : dist;
                const bool ok = (dist <= 128) && (t >= 0) && (t < T);
                const float lg = ok ? st[kt][r] - slope * (float)dist : -INFINITY; st[kt][r] = lg; mx = fmaxf(mx, lg); }
        mx = fmaxf(mx, __shfl_xor(mx, 16)); mx = fmaxf(mx, __shfl_xor(mx, 32));
        float sum = 0.f;
#pragma unroll
        for (int kt = 0; kt < 18; ++kt)
#pragma unroll
            for (int r = 0; r < 4; ++r) { const float p = __expf(st[kt][r] - mx); st[kt][r] = p; sum += p; }
        sum += __shfl_xor(sum, 16); sum += __shfl_xor(sum, 32);
        const float inv = 1.f / (sum + __expf(sink - mx));
        f32x4 ot[4];
#pragma unroll
        for (int dt = 0; dt < 4; ++dt) ot[dt] = (f32x4){0.f, 0.f, 0.f, 0.f};
#pragma unroll
        for (int kk = 0; kk < 9; ++kk) {
            v4u pb; pb.x = pk2(st[2 * kk][0], st[2 * kk][1]); pb.y = pk2(st[2 * kk][2], st[2 * kk][3]); pb.z = pk2(st[2 * kk + 1][0], st[2 * kk + 1][1]); pb.w = pk2(st[2 * kk + 1][2], st[2 * kk + 1][3]);
#pragma unroll
            for (int dt = 0; dt < 4; ++dt) { const LAS bf16* vp = VT + prow(dt * 16 + fr) * WV_S + i0 + 32 * kk + 4 * fq;
                const v2u lo = *(const LAS v2u*)vp, hi = *(const LAS v2u*)(vp + 16); v4u va; va.x = lo.x; va.y = lo.y; va.z = hi.x; va.w = hi.y;
                ot[dt] = mfma16(as_frag(va), as_frag(pb), ot[dt]); }
        }
        const size_t row = (size_t)(m0 + i0 + fr);
#pragma unroll
        for (int dt = 0; dt < 4; ++dt) { const int d = H * 64 + dt * 16 + 4 * fq; const v2u z = *(const v2u*)(PROJ + row * PLD + C_ZATT + d);
            v2u o; o.x = pk2(ot[dt][0] * inv * silu(bf_lo(z.x)), ot[dt][1] * inv * silu(bf_hi(z.x))); o.y = pk2(ot[dt][2] * inv * silu(bf_lo(z.y)), ot[dt][3] * inv * silu(bf_hi(z.y)));
            if (EXPT == 2) { o.x = 0u; o.y = 0u; } *(v2u*)(CC + row * DM + 1024 + d) = o; }
    }
    __syncthreads();
}

constexpr int MK_S = 136, MV_S = 264;
__device__ __forceinline__ void mem_attn_item(LAS unsigned char* lds, const Params& P, int item) {
    const int tid = threadIdx.x, lane = tid & 63, w = tid >> 6, fr = lane & 15, fq = lane >> 4;
    const int cgi = item >> 2, hm = item & 3;
    int T, t0, bg; chunk_info(cgi, T, t0, bg);
    const int m0 = cgi * 128;
    const bf16* PROJ = (const bf16*)(P.ws + WS_PROJ); const bf16* MKV = (const bf16*)(P.ws + WS_MKV); bf16* CC = (bf16*)(P.ws + WS_CC);
    LAS bf16* MKs = (LAS bf16*)lds;
    LAS bf16* MVT = MKs + 256 * MK_S;
    {
        const int ch = tid & 15, j0 = (tid >> 4) * 8;
        const f32x4 g0 = *(const f32x4*)(P.mk_norm_g + ch * 8), g1 = *(const f32x4*)(P.mk_norm_g + ch * 8 + 4);
        v4u kin[8], vin[8], vout[8];
#pragma unroll
        for (int k = 0; k < 8; ++k) { const bf16* rowp = MKV + (size_t)(bg * 256 + j0 + k) * 1024 + hm * 128 + ch * 8; kin[k] = *(const v4u*)rowp; vin[k] = *(const v4u*)(rowp + 512); }
        __builtin_amdgcn_sched_barrier(0);
#pragma unroll
        for (int k = 0; k < 8; ++k) { const int mm = j0 + k; float kv[8];
            unpack8(kin[k], kv);
            float ss = 0.f;
#pragma unroll
            for (int e = 0; e < 8; ++e) ss += kv[e] * kv[e];
            ss += __shfl_xor(ss, 1); ss += __shfl_xor(ss, 2); ss += __shfl_xor(ss, 4); ss += __shfl_xor(ss, 8);
            const float rstd = rsqrtf(ss * (1.f / 128.f) + EPS);
            kv[0] *= rstd * g0.x; kv[1] *= rstd * g0.y; kv[2] *= rstd * g0.z; kv[3] *= rstd * g0.w; kv[4] *= rstd * g1.x; kv[5] *= rstd * g1.y; kv[6] *= rstd * g1.z; kv[7] *= rstd * g1.w;
            *(LAS v4u*)(MKs + mm * MK_S + ch * 8) = pack8(kv); }
        transpose8x8_bf16(vin, vout);
#pragma unroll
        for (int e = 0; e < 8; ++e) *(LAS v4u*)(MVT + prow(ch * 8 + e) * MV_S + j0) = vout[e];
    }
    __syncthreads();
    const int i0 = w * 16;
    bf16x8 qf[4];
    { float qv[4][8]; const bf16* qp = PROJ + (size_t)(m0 + i0 + fr) * PLD + C_MQ + hm * 128 + 8 * fq; float ss = 0.f;
#pragma unroll
      for (int ks = 0; ks < 4; ++ks) { unpack8(*(const v4u*)(qp + ks * 32), qv[ks]);
#pragma unroll
          for (int e = 0; e < 8; ++e) ss += qv[ks][e] * qv[ks][e]; }
      ss += __shfl_xor(ss, 16); ss += __shfl_xor(ss, 32);
      const float sc = rsqrtf(ss * (1.f / 128.f) + EPS) * 0.08838834764831845f;
#pragma unroll
      for (int ks = 0; ks < 4; ++ks) { const f32x4 ga = *(const f32x4*)(P.mq_norm_g + ks * 32 + 8 * fq), gb = *(const f32x4*)(P.mq_norm_g + ks * 32 + 8 * fq + 4);
          qv[ks][0] *= sc * ga.x; qv[ks][1] *= sc * ga.y; qv[ks][2] *= sc * ga.z; qv[ks][3] *= sc * ga.w; qv[ks][4] *= sc * gb.x; qv[ks][5] *= sc * gb.y; qv[ks][6] *= sc * gb.z; qv[ks][7] *= sc * gb.w;
          qf[ks] = as_frag(pack8(qv[ks])); } }
    f32x4 st[16];
#pragma unroll
    for (int kt = 0; kt < 16; ++kt) {
        f32x4 a = {0.f, 0.f, 0.f, 0.f};
#pragma unroll
        for (int ks = 0; ks < 4; ++ks) a = mfma16(as_frag(*(const LAS v4u*)(MKs + (kt * 16 + fr) * MK_S + ks * 32 + 8 * fq)), qf[ks], a);
        st[kt] = a;
    }
    float mx = -INFINITY;
#pragma unroll
    for (int kt = 0; kt < 16; ++kt)
#pragma unroll
        for (int r = 0; r < 4; ++r) mx = fmaxf(mx, st[kt][r]);
    mx = fmaxf(mx, __shfl_xor(mx, 16)); mx = fmaxf(mx, __shfl_xor(mx, 32));
    float sum = 0.f;
#pragma unroll
    for (int kt = 0; kt < 16; ++kt)
#pragma unroll
        for (int r = 0; r < 4; ++r) { const float p = __expf(st[kt][r] - mx); st[kt][r] = p; sum += p; }
    sum += __shfl_xor(sum, 16); sum += __shfl_xor(sum, 32);
    const float inv = 1.f / sum;
    f32x4 ot[8];
#pragma unroll
    for (int dt = 0; dt < 8; ++dt) ot[dt] = (f32x4){0.f, 0.f, 0.f, 0.f};
#pragma unroll
    for (int kk = 0; kk < 8; ++kk) {
        v4u pb; pb.x = pk2(st[2 * kk][0], st[2 * kk][1]); pb.y = pk2(st[2 * kk][2], st[2 * kk][3]); pb.z = pk2(st[2 * kk + 1][0], st[2 * kk + 1][1]); pb.w = pk2(st[2 * kk + 1][2], st[2 * kk + 1][3]);
#pragma unroll
        for (int dt = 0; dt < 8; ++dt) { const LAS bf16* vp = MVT + prow(dt * 16 + fr) * MV_S + 32 * kk + 4 * fq;
            const v2u lo = *(const LAS v2u*)vp, hi = *(const LAS v2u*)(vp + 16); v4u va; va.x = lo.x; va.y = lo.y; va.z = hi.x; va.w = hi.y;
            ot[dt] = mfma16(as_frag(va), as_frag(pb), ot[dt]); }
    }
    const size_t row = (size_t)(m0 + i0 + fr);
#pragma unroll
    for (int dt = 0; dt < 8; ++dt) { const int d = hm * 128 + dt * 16 + 4 * fq; const v2u z = *(const v2u*)(PROJ + row * PLD + C_ZMEM + d);
        v2u o; o.x = pk2(ot[dt][0] * inv * silu(bf_lo(z.x)), ot[dt][1] * inv * silu(bf_hi(z.x))); o.y = pk2(ot[dt][2] * inv * silu(bf_lo(z.y)), ot[dt][3] * inv * silu(bf_hi(z.y)));
        if (EXPT == 2) { o.x = 0u; o.y = 0u; } *(v2u*)(CC + row * DM + 1536 + d) = o; }
    __syncthreads();
}

__device__ __forceinline__ void scan_phase(const Params& P) {
    const bf16* ST = (const bf16*)(P.ws + WS_ST); bf16* SP = (bf16*)((unsigned char*)P.out + OUT_SP); const float* CD = (const float*)(P.ws + WS_CD);
    for (int idx = blockIdx.x * 512 + threadIdx.x; idx < 262144; idx += gridDim.x * 512) {
        const int n8 = idx & 15, p = (idx >> 4) & 63, h = (idx >> 10) & 15, dir = (idx >> 14) & 1, bgi = idx >> 15;
        const int cg0 = bgi < 4 ? bgi * 16 : 64 + (bgi - 4) * 64, nc = bgi < 4 ? 16 : 64;
        float S[8];
#pragma unroll
        for (int e = 0; e < 8; ++e) S[e] = 0.f;
        for (int s0 = 0; s0 < nc; s0 += 4) {
            v4u raw[4]; float cd[4]; size_t off[4];
#pragma unroll
            for (int u = 0; u < 4; ++u) { const int c = dir ? nc - 1 - (s0 + u) : s0 + u, cgi = cg0 + c;
                off[u] = (((size_t)(cgi * 2 + dir) * 16 + h) * 64 + p) * 128 + n8 * 8; raw[u] = *(const v4u*)(ST + off[u]); cd[u] = CD[(cgi * 4 + (h >> 2)) * 32 + dir * 4 + (h & 3)]; }
#pragma unroll
            for (int u = 0; u < 4; ++u) { float st[8]; unpack8(raw[u], st); *(v4u*)(SP + off[u]) = pack8(S);
#pragma unroll
                for (int e = 0; e < 8; ++e) S[e] = cd[u] * S[e] + st[e]; }
        }
    }
}

__device__ __forceinline__ void ssd_y_item(LAS unsigned char* lds, const Params& P, int item) {
    const int tid = threadIdx.x, lane = tid & 63, w = __builtin_amdgcn_readfirstlane(tid >> 6), fr = lane & 15, fq = lane >> 4;
    const int cgi = item >> 1, g = item & 1, head = g * 8 + w;
    const int m0 = cgi * 128;
    const bf16* PROJ = (const bf16*)(P.ws + WS_PROJ); const float* DT = (const float*)(P.ws + WS_DT);
    const bf16* BN = (const bf16*)(P.ws + WS_BN); const bf16* CN = (const bf16*)(P.ws + WS_CN); const bf16* XTg = (const bf16*)(P.ws + WS_XT); const bf16* ST = (const bf16*)((const unsigned char*)P.out + OUT_SP);
    bf16* CC = (bf16*)(P.ws + WS_CC);
    LAS bf16* Cs = (LAS bf16*)lds;
    LAS bf16* CBs = Cs + 128 * TS;
    LAS bf16* Bs = CBs + 128 * TS;
    LAS float* PF = (LAS float*)(Bs + 128 * TS);
    LAS float* RB = PF + 1024;
    LAS float* DF = RB + 1024;
    LAS float* DB = DF + 1024;
    LAS float* SQ = DB + 1024;
    LAS float* RS = SQ + 2048;
    LAS float* SCR = RS + 128;
    {
#pragma unroll
        for (int dir = 0; dir < 2; ++dir) {
            const float bias = P.dt_bias[dir * 16 + head], A = -__expf(P.a_log[dir * 16 + head]);
            const float r0 = DT[(size_t)(m0 + 2 * lane) * 32 + dir * 16 + head], r1 = DT[(size_t)(m0 + 2 * lane + 1) * 32 + dir * 16 + head];
            const float d0 = softplus(r0 + bias), d1 = softplus(r1 + bias), a0 = d0 * A, a1 = d1 * A;
            float tot; const float inc = wave_incl_scan(a0 + a1, lane, SCR + w * 64, tot);
            const float p1 = inc, p0 = inc - a1;
            if (dir == 0) { PF[w * 128 + 2 * lane] = p0; PF[w * 128 + 2 * lane + 1] = p1; DF[w * 128 + 2 * lane] = d0; DF[w * 128 + 2 * lane + 1] = d1; }
            else { RB[w * 128 + 2 * lane] = tot - p0 + a0; RB[w * 128 + 2 * lane + 1] = tot - p1 + a1; DB[w * 128 + 2 * lane] = d0; DB[w * 128 + 2 * lane + 1] = d1; }
        }
    }
    for (int q = tid; q < 4096; q += 512) { const int qq = q & 2047, c8 = qq & 15, j = qq >> 4;
        if (q < 2048) *(LAS v4u*)(Cs + j * TS + c8 * 8) = *(const v4u*)(CN + (size_t)(m0 + j) * 256 + g * 128 + c8 * 8);
        else *(LAS v4u*)(Bs + j * TS + c8 * 8) = *(const v4u*)(BN + (size_t)(m0 + j) * 256 + g * 128 + c8 * 8); }
    __syncthreads();
    {
        f32x4 cb[8];
#pragma unroll
        for (int jt = 0; jt < 8; ++jt) cb[jt] = (f32x4){0.f, 0.f, 0.f, 0.f};
#pragma unroll
        for (int ks = 0; ks < 4; ++ks) { const bf16x8 a = as_frag(*(const LAS v4u*)(Cs + (w * 16 + fr) * TS + ks * 32 + 8 * fq));
#pragma unroll
            for (int jt = 0; jt < 8; ++jt) cb[jt] = mfma16(a, as_frag(*(const LAS v4u*)(Bs + (jt * 16 + fr) * TS + ks * 32 + 8 * fq)), cb[jt]); }
#pragma unroll
        for (int jt = 0; jt < 8; ++jt)
#pragma unroll
            for (int r = 0; r < 4; ++r) CBs[(w * 16 + 4 * fq + r) * TS + jt * 16 + fr] = f2bf(cb[jt][r]);
    }
    __syncthreads();
    const float Dh = P.d_skip[head];
    const char* SpF = (const char*)(ST + ((size_t)(cgi * 2 + 0) * 16 + head) * 8192); const char* SpB = SpF + (size_t)16 * 8192 * 2;
    const char* Xp = (const char*)(XTg + ((size_t)cgi * 1024 + head * 64) * 128);
#define LD8(dst, arr) do { const f32x4 _a = *(const LAS f32x4*)((arr) + w * 128 + jb), _b = *(const LAS f32x4*)((arr) + w * 128 + jb + 4); \
        dst[0] = _a.x; dst[1] = _a.y; dst[2] = _a.z; dst[3] = _a.w; dst[4] = _b.x; dst[5] = _b.y; dst[6] = _b.z; dst[7] = _b.w; } while (0)
#pragma unroll 1
    for (int ph = 0; ph < 2; ++ph) {
        f32x4 acc[8][2];
#pragma unroll
        for (int it = 0; it < 8; ++it) { acc[it][0] = (f32x4){0.f, 0.f, 0.f, 0.f}; acc[it][1] = (f32x4){0.f, 0.f, 0.f, 0.f}; }
        const unsigned vo0 = (unsigned)((((2 * ph) * 16 + fr) * 128 + 8 * fq) * 2), vo1 = vo0 + 16 * 128 * 2;
#pragma unroll 1
        for (int s = 0; s < 8; ++s) {
            const int ks = s & 3, jb = ks * 32 + 8 * fq; const char* base = (s < 4 ? SpF : SpB) + ks * 64;
            unsigned va = vo0, vb = vo1; asm volatile("" : "+v"(va), "+v"(vb));
            const bf16x8 f0 = as_frag(*(const v4u*)(base + va)), f1 = as_frag(*(const v4u*)(base + vb));
            const LAS float* cum = (s < 4 ? PF : RB) + w * 128;
#pragma unroll
            for (int it = 0; it < 8; ++it) { const int i = it * 16 + fr; const float sc = __expf(cum[i]); float cv[8]; unpack8(*(const LAS v4u*)(Cs + i * TS + jb), cv);
#pragma unroll
                for (int e = 0; e < 8; ++e) cv[e] *= sc;
                const bf16x8 a = as_frag(pack8(cv));
                acc[it][0] = mfma16(f0, a, acc[it][0]); acc[it][1] = mfma16(f1, a, acc[it][1]); }
        }
#pragma unroll 1
        for (int ks = 0; ks < 4; ++ks) {
            const int jb = ks * 32 + 8 * fq; const char* base = Xp + ks * 64;
            unsigned va = vo0, vb = vo1; asm volatile("" : "+v"(va), "+v"(vb));
            const bf16x8 f0 = as_frag(*(const v4u*)(base + va)), f1 = as_frag(*(const v4u*)(base + vb));
            const float pref = PF[w * 128 + ks * 32 + 31], rref = RB[w * 128 + ks * 32];
#pragma unroll
            for (int it = 0; it < 8; ++it) { const int i = it * 16 + fr; const float pi = PF[w * 128 + i], ri = RB[w * 128 + i];
                const int rel = it * 16 - ks * 32;
                float cv[8]; unpack8(*(const LAS v4u*)(CBs + i * TS + jb), cv);
                if (rel >= 32) { const float ei = __expf(fminf(pi - pref, 0.f)); float pj[8], dfj[8]; LD8(pj, PF); LD8(dfj, DF);
#pragma unroll
                    for (int e = 0; e < 8; ++e) cv[e] *= ei * (__expf(fminf(pref - pj[e], 0.f)) * dfj[e]); }
                else if (rel <= -16) { const float ei = __expf(fminf(ri - rref, 0.f)); float rj[8], dbj[8]; LD8(rj, RB); LD8(dbj, DB);
#pragma unroll
                    for (int e = 0; e < 8; ++e) cv[e] *= ei * (__expf(fminf(rref - rj[e], 0.f)) * dbj[e]); }
                else { float tf[8]; const float dsum = DF[w * 128 + i] + DB[w * 128 + i];
                    { float pj[8], dfj[8]; LD8(pj, PF); LD8(dfj, DF);
#pragma unroll
                      for (int e = 0; e < 8; ++e) tf[e] = __expf(fminf(pi - pj[e], 0.f)) * dfj[e]; }
                    __builtin_amdgcn_sched_barrier(0);
                    { float rj[8], dbj[8]; LD8(rj, RB); LD8(dbj, DB);
#pragma unroll
                      for (int e = 0; e < 8; ++e) { const int j = jb + e; const float eb = __expf(fminf(ri - rj[e], 0.f)) * dbj[e];
                          const float m = j < i ? tf[e] : (j > i ? eb : dsum); cv[e] = cv[e] * m + (j == i ? Dh : 0.f); } } }
                const bf16x8 a = as_frag(pack8(cv));
                acc[it][0] = mfma16(f0, a, acc[it][0]); acc[it][1] = mfma16(f1, a, acc[it][1]);
                __builtin_amdgcn_sched_barrier(0); }
        }
        char* cb2 = (char*)(CC + (size_t)m0 * DM + head * 64 + ph * 32);
#pragma unroll
        for (int it = 0; it < 8; ++it) { unsigned vc = (unsigned)(((it * 16 + fr) * DM + 4 * fq) * 2); asm volatile("" : "+v"(vc));
#pragma unroll
            for (int ptl = 0; ptl < 2; ++ptl) { v2u o; o.x = pk2(acc[it][ptl][0], acc[it][ptl][1]); o.y = pk2(acc[it][ptl][2], acc[it][ptl][3]); *(v2u*)(cb2 + vc + ptl * 32) = o; } }
    }
#undef LD8
    asm volatile("s_waitcnt vmcnt(0)" ::: "memory");
    __syncthreads();
    {
        const f32x4 g0 = *(const f32x4*)(P.ssd_norm_g + g * 512 + lane * 8), g1 = *(const f32x4*)(P.ssd_norm_g + g * 512 + lane * 8 + 4);
        bf16* crow = CC + (size_t)(m0 + w * 16) * DM + g * 512 + lane * 8; const bf16* zrow = PROJ + (size_t)(m0 + w * 16) * PLD + C_ZSSD + g * 512 + lane * 8;
#pragma unroll 1
        for (int kb = 0; kb < 2; ++kb) {
            v4u yv[8], zv[8];
#pragma unroll
            for (int k = 0; k < 8; ++k) { yv[k] = __builtin_nontemporal_load((const v4u*)(crow + (size_t)(kb * 8 + k) * DM)); zv[k] = *(const v4u*)(zrow + (size_t)(kb * 8 + k) * PLD); }
#pragma unroll
            for (int k = 0; k < 8; ++k) { float y[8], z[8]; unpack8(yv[k], y); unpack8(zv[k], z); float s = 0.f;
#pragma unroll
                for (int e = 0; e < 8; ++e) { y[e] *= silu(z[e]); s += y[e] * y[e]; }
                const float rs = rsqrtf(wave_sum(s) * (1.f / 512.f) + EPS);
                y[0] *= rs * g0.x; y[1] *= rs * g0.y; y[2] *= rs * g0.z; y[3] *= rs * g0.w; y[4] *= rs * g1.x; y[5] *= rs * g1.y; y[6] *= rs * g1.z; y[7] *= rs * g1.w;
                v4u o = pack8(y); if (EXPT == 1) o = (v4u){0u, 0u, 0u, 0u};
                *(v4u*)(crow + (size_t)(kb * 8 + k) * DM) = o; }
        }
    }
    __syncthreads();
}

#define RLX_AGENT __ATOMIC_RELAXED, __HIP_MEMORY_SCOPE_AGENT
#define XB_TMO      128
#define XB_XCNT(j)  (256  + 64 * (j))
#define XB_XSUB(j)  (1280 + 64 * (j))
#define XB_XGEN(j)  (2304 + 64 * (j))
#define XB_TOP      3328
#define XB_TOPGEN   3392
#define XCD_BAR_WORDS 3456
#define XB_SPIN_CAP (1u << 18)

__device__ __forceinline__ unsigned xb_ld(unsigned* p)              { return __hip_atomic_load(p, __ATOMIC_RELAXED, __HIP_MEMORY_SCOPE_AGENT); }
__device__ __forceinline__ unsigned xb_add(unsigned* p, unsigned v) { return __hip_atomic_fetch_add(p, v, __ATOMIC_RELAXED, __HIP_MEMORY_SCOPE_AGENT); }
__device__ __forceinline__ unsigned xb_xcc_id() { return (unsigned)__builtin_amdgcn_s_getreg((3 << 11) | 20) & 0xFu; }
#define XB_SPIN(cond, bar) do { unsigned _sp = 0; while (cond) { __builtin_amdgcn_s_sleep(1); \
    if ((++_sp & 255u) == 0u) { if (xb_ld(&(bar)[XB_TMO])) break; if (_sp > XB_SPIN_CAP) { atomicAdd(&(bar)[XB_TMO], 1u); break; } } } } while (0)

struct XcdBarrier {
    unsigned* bar; unsigned x;
    volatile LAS unsigned* st;
};

__device__ __forceinline__ XcdBarrier xcd_barrier_post(unsigned* bar, volatile LAS unsigned* st) {
    XcdBarrier b; b.bar = bar; b.x = xb_xcc_id(); b.st = st;
    if (threadIdx.x == 0) (void)xb_add(&bar[XB_XCNT(b.x)], 1u);
    return b;
}
__device__ __forceinline__ void xcd_barrier_complete(unsigned* bar, unsigned x, unsigned& nloc, unsigned& nx) {
    const unsigned G = gridDim.x * gridDim.y * gridDim.z;
    unsigned sum, cnt, mine, sp = 0u;
    for (;;) {
        sum = 0u; cnt = 0u; mine = 0u;
#pragma unroll
        for (unsigned j = 0; j < 16; ++j) { const unsigned c = xb_ld(&bar[XB_XCNT(j)]); sum += c; cnt += (c > 0u) ? 1u : 0u; mine = (j == x) ? c : mine; }
        if (sum == G) break;
        __builtin_amdgcn_s_sleep(1);
        if ((++sp & 255u) == 0u) { if (xb_ld(&bar[XB_TMO])) break; if (sp > XB_SPIN_CAP) { atomicAdd(&bar[XB_TMO], 1u); break; } }
    }
    nloc = mine > 0u ? mine : 1u; nx = cnt > 0u ? cnt : 1u;
}

__device__ __forceinline__ void xcd_barrier(const XcdBarrier& b) {
    asm volatile("s_waitcnt vmcnt(0)" ::: "memory");
    __syncthreads();
    if (threadIdx.x == 0) {
        unsigned* bar = b.bar;
        __builtin_amdgcn_s_waitcnt(0);
        unsigned nloc = b.st[0], nx = b.st[1];
        if (nloc == 0u) { xcd_barrier_complete(bar, b.x, nloc, nx); b.st[0] = nloc; b.st[1] = nx; }
        const unsigned old = xb_add(&bar[XB_XSUB(b.x)], 1u);
        const unsigned gen = old / nloc;
        if (old + 1u == (gen + 1u) * nloc) {
            __builtin_amdgcn_fence(__ATOMIC_RELEASE, "agent");
            asm volatile("s_waitcnt vmcnt(0)" ::: "memory");
            const unsigned og = xb_add(&bar[XB_TOP], 1u);
            const unsigned tg = og / nx;
            if (og + 1u == (tg + 1u) * nx) xb_add(&bar[XB_TOPGEN], 1u);
            else XB_SPIN(xb_ld(&bar[XB_TOPGEN]) == tg, bar);
            __builtin_amdgcn_fence(__ATOMIC_ACQUIRE, "agent");
            xb_add(&bar[XB_XGEN(b.x)], 1u);
            asm volatile("s_waitcnt vmcnt(0)" ::: "memory");
        } else {
            XB_SPIN(xb_ld(&bar[XB_XGEN(b.x)]) == gen, bar);
            __builtin_amdgcn_fence(__ATOMIC_ACQUIRE, "agent");
            asm volatile("s_waitcnt vmcnt(0)" ::: "memory");
        }
    }
    __syncthreads();
}

__global__ void __launch_bounds__(512, 2) hymba_fwd(Params P) {
    extern __shared__ __attribute__((aligned(16))) unsigned char lds_raw[];
    LAS unsigned char* lds = (LAS unsigned char*)lds_raw;
    if (P.ws == nullptr) cg::this_grid().sync();
    if (threadIdx.x < 8) ((LAS unsigned*)(lds + LDS_BYTES - 32))[threadIdx.x] = 0u;
    __syncthreads();
    XcdBarrier bar = xcd_barrier_post((unsigned*)(P.ws + WS_BAR), (volatile LAS unsigned*)(lds + LDS_BYTES - 32));
#define GRID_SYNC() xcd_barrier(bar)
    const int G = gridDim.x, c = blockIdx.x;

    p0_prologue(lds, P);
    GRID_SYNC();

    {
        pg8::Gemm g1{(const bf16*)((const unsigned char*)P.out + OUT_XN), (const bf16*)(P.ws + WS_WIN), MTOT, DINP, DM}; pg8::StaticOrder S1; S1.init(MTOT, DINP, G, c);
        EpiProj E1{(bf16*)(P.ws + WS_PROJ), (float*)(P.ws + WS_DT)};
        pg8::gemm_phase<EpiProj, pg8::StaticOrder, true, true>(lds, g1, S1, E1);
        pg8::Gemm g2{(const bf16*)(P.ws + WS_MEMN), (const bf16*)(P.ws + WS_WMEM), 2048, 1024, DM}; MemOrder S2{c, G};
        EpiPlain E2{(bf16*)(P.ws + WS_MKV), 1024};
        pg8::gemm_phase<EpiPlain, MemOrder, true, true>(lds, g2, S2, E2);
    }
    GRID_SYNC();

    unsigned* ctr = (unsigned*)P.ws;
    LAS volatile int* slot = (LAS volatile int*)(lds + LDS_BYTES - 16);
#define RUN_QUEUE(CTR, NITEMS, BODY) do { \
        int it_; if (threadIdx.x == 0) slot[0] = (int)__hip_atomic_fetch_add((CTR), 1u, __ATOMIC_RELAXED, __HIP_MEMORY_SCOPE_AGENT); \
        __syncthreads(); it_ = slot[0]; __syncthreads(); \
        while (it_ < (NITEMS)) { \
            int nxt_ = 0; if (threadIdx.x == 0) nxt_ = (int)__hip_atomic_fetch_add((CTR), 1u, __ATOMIC_RELAXED, __HIP_MEMORY_SCOPE_AGENT); \
            { const int it = it_; BODY } \
            if (threadIdx.x == 0) slot[0] = nxt_; \
            __syncthreads(); it_ = slot[0]; __syncthreads(); \
        } } while (0)
    {
        unsigned* cq = ctr + 256;
        int q = (int)(bar.x & 7u), tries = 0, t;
        for (;;) {
            if (threadIdx.x == 0) slot[0] = (int)__hip_atomic_fetch_add(cq + 64 * q, 1u, __ATOMIC_RELAXED, __HIP_MEMORY_SCOPE_AGENT);
            __syncthreads(); t = slot[0]; __syncthreads();
            if (t < 240) break;
            if (++tries == 8) { t = -1; break; }
            q = (q + 1) & 7;
        }
        while (t >= 0) {
            int nxt = 0; if (threadIdx.x == 0) nxt = (int)__hip_atomic_fetch_add(cq + 64 * q, 1u, __ATOMIC_RELAXED, __HIP_MEMORY_SCOPE_AGENT);
            if (t < 80) win_attn_item(lds, P, (q * 40 + (t >> 1)) * 2 + (t & 1));
            else { const int u = t - 80; ssd_state_item(lds, P, (q * 40 + (u >> 2)) * 4 + (u & 3)); }
            if (threadIdx.x == 0) slot[0] = nxt;
            __syncthreads(); t = slot[0]; __syncthreads();
            while (t >= 240) {
                if (++tries >= 8) { t = -1; break; }
                q = (q + 1) & 7;
                if (threadIdx.x == 0) slot[0] = (int)__hip_atomic_fetch_add(cq + 64 * q, 1u, __ATOMIC_RELAXED, __HIP_MEMORY_SCOPE_AGENT);
                __syncthreads(); t = slot[0]; __syncthreads();
            }
        }
    }
    GRID_SYNC();

    scan_phase(P);
    GRID_SYNC();

    RUN_QUEUE(ctr + 64, 640, ssd_y_item(lds, P, it););
    RUN_QUEUE(ctr + 128, 1280, mem_attn_item(lds, P, it););
    GRID_SYNC();
#undef RUN_QUEUE

    {
        pg8::Gemm g5{(const bf16*)(P.ws + WS_CC), (const bf16*)(P.ws + WS_WOUT), MTOT, DM, DM}; pg8::StaticOrder S5; S5.init(MTOT, DM, G, c);
        EpiOut E5{P.x_prompt, P.x_sample, P.out};
        pg8::gemm_phase<EpiOut, pg8::StaticOrder, true, true>(lds, g5, S5, E5);
    }
}

extern "C" void kernel_launch(void* const* d_in, const int* in_sizes, int n_in, void* d_out, int out_size, void* d_ws, size_t ws_size, hipStream_t stream) {
    static int grid = 0;
    if (grid == 0) {
        if (n_in != 20 || out_size != MTOT * DM || ws_size < WS_END) { fprintf(stderr, "kernel_launch: unexpected problem (n_in %d, out %d, ws %zu)\n", n_in, out_size, ws_size); grid = -1; return; }
        int dev = 0, cus = 0, per_cu = 0;
        hipGetDevice(&dev); hipDeviceGetAttribute(&cus, hipDeviceAttributeMultiprocessorCount, dev);
        if (hipFuncSetAttribute((const void*)hymba_fwd, hipFuncAttributeMaxDynamicSharedMemorySize, LDS_BYTES) != hipSuccess) { fprintf(stderr, "kernel_launch: hipFuncSetAttribute failed\n"); grid = -1; return; }
        if (hipOccupancyMaxActiveBlocksPerMultiprocessor(&per_cu, (const void*)hymba_fwd, 512, LDS_BYTES) != hipSuccess || per_cu < 1) { fprintf(stderr, "kernel_launch: occupancy query says %d\n", per_cu); per_cu = 1; }
        (void)hipGetLastError();
        grid = cus;
    }
    if (grid < 0) return;
    if (hipMemsetAsync(d_ws, 0, WS_CTL_BYTES, stream) != hipSuccess) { fprintf(stderr, "kernel_launch: hipMemsetAsync failed\n"); return; }
    Params p{};
    const float** f = (const float**)&p;
    for (int i = 0; i < 20; ++i) f[i] = (const float*)d_in[i];
    p.out = (float*)d_out; p.ws = (unsigned char*)d_ws;
    void* args[] = {&p};
    hipError_t e = hipLaunchCooperativeKernel((const void*)hymba_fwd, dim3(grid), dim3(512), args, LDS_BYTES, stream);
    if (e != hipSuccess) fprintf(stderr, "cooperative launch failed: %s (grid %d)\n", hipGetErrorString(e), grid);
}
```
